# Optimizing an MI355X kernel written in HIP

```python
import jax, jax.numpy as jnp
from jax import lax
import numpy as np

D_MODEL = 2048
BATCH = 4
SEQ = 2048
DEPTH = 2

N_MEM = 256
MIX_WIDTH = D_MODEL
GM_WIDTH = MIX_WIDTH // 2
GM_HEAD_DIM = 128
GM_HEADS = GM_WIDTH // GM_HEAD_DIM
GM_CHUNK = 128
DN_WIDTH = MIX_WIDTH - GM_WIDTH
DN_HEAD_DIM = 128
DN_HEADS = DN_WIDTH // DN_HEAD_DIM
DN_CHUNK = 64
CONV_WIDTH = 4
XA_HEADS = 4
XA_HEAD_DIM = D_MODEL // XA_HEADS
D_FF = 5632
NORM_EPS = 1e-6
IN_COLS = 2 * GM_WIDTH + 4 * DN_WIDTH + 2 * DN_HEADS

kernel_name = "hybrid_sgu_deltanet_macaron_block"


def rmsnorm(x, g):
    xf = x.astype(jnp.float32)
    y = xf * lax.rsqrt(jnp.mean(xf * xf, axis=-1, keepdims=True) + NORM_EPS)
    return (y * g.astype(jnp.float32)).astype(x.dtype)


def l2norm(x):
    xf = x.astype(jnp.float32)
    return xf * lax.rsqrt(jnp.sum(xf * xf, axis=-1, keepdims=True) + NORM_EPS)


def swiglu_ffn(h, w_gate_up, w_down):
    gate, up = jnp.split(h @ w_gate_up, 2, axis=-1)
    return (jax.nn.silu(gate) * up) @ w_down


def causal_short_conv(x, w):
    k_width = w.shape[0]
    t_len = x.shape[1]
    xp = jnp.pad(x, ((0, 0), (k_width - 1, 0), (0, 0)))
    out = xp[:, 0:t_len] * w[0]
    for i in range(1, k_width):
        out = out + xp[:, i:i + t_len] * w[i]
    return out


def chunk_spatial_gating(u, v, sm_w, sm_b, ln_g, ln_b):
    b_, t_len, _ = u.shape
    n_chunks = t_len // GM_CHUNK
    u = jax.nn.gelu(u, approximate=False)
    vf = jax.nn.gelu(v, approximate=False).astype(jnp.float32)
    mu = jnp.mean(vf, axis=-1, keepdims=True)
    var = jnp.mean(jnp.square(vf - mu), axis=-1, keepdims=True)
    vn = ((vf - mu) * lax.rsqrt(var + NORM_EPS) * ln_g + ln_b).astype(u.dtype)
    vc = vn.reshape(b_, n_chunks, GM_CHUNK, GM_HEADS, GM_HEAD_DIM)
    causal = jnp.tril(jnp.ones((GM_CHUNK, GM_CHUNK), dtype=bool))
    w_masked = jnp.where(causal, sm_w, 0)
    mixed = jnp.einsum('hts,bnshd->bnthd', w_masked, vc) + sm_b.T[None, None, :, :, None]
    uc = u.reshape(b_, n_chunks, GM_CHUNK, GM_HEADS, GM_HEAD_DIM)
    return (uc * mixed).reshape(b_, t_len, GM_WIDTH)


def gated_delta_rule(q, k, v, g, beta):
    b_, t_len, h_, dk = q.shape
    dv = v.shape[-1]
    n_chunks = t_len // DN_CHUNK
    c = DN_CHUNK

    def to_chunks(a):
        return a.reshape(b_, n_chunks, c, h_, -1).transpose(1, 0, 3, 2, 4)

    qc = to_chunks(l2norm(q) * (dk ** -0.5))
    kc = to_chunks(l2norm(k))
    vc = to_chunks(v.astype(jnp.float32))
    gc = g.astype(jnp.float32).reshape(b_, n_chunks, c, h_).transpose(1, 0, 3, 2)
    bc = beta.astype(jnp.float32).reshape(b_, n_chunks, c, h_).transpose(1, 0, 3, 2)
    gcum = jnp.cumsum(gc, axis=-1)

    causal = jnp.tril(jnp.ones((c, c), dtype=bool))
    strict = jnp.tril(jnp.ones((c, c), dtype=bool), k=-1)
    decay = jnp.exp(jnp.where(causal, gcum[..., :, None] - gcum[..., None, :], -jnp.inf))

    k_beta = kc * bc[..., None]
    kkt = jnp.einsum('nbhtd,nbhsd->nbhts', k_beta, kc) * decay
    a_mat = jnp.eye(c, dtype=jnp.float32) + jnp.where(strict, kkt, 0.0)
    rhs = jnp.concatenate([vc * bc[..., None], k_beta * jnp.exp(gcum)[..., None]], axis=-1)
    sol = lax.linalg.triangular_solve(a_mat, rhs, left_side=True, lower=True, unit_diagonal=True)
    u_c, w_c = sol[..., :dv], sol[..., dv:]
    qk_intra = jnp.where(causal, jnp.einsum('nbhtd,nbhsd->nbhts', qc, kc) * decay, 0.0)

    def chunk_step(state, inp):
        q_i, k_i, u_i, w_i, g_i, a_i = inp
        v_new = u_i - jnp.einsum('bhck,bhkv->bhcv', w_i, state)
        o_i = (jnp.einsum('bhck,bhkv->bhcv', q_i * jnp.exp(g_i)[..., None], state)
               + jnp.einsum('bhts,bhsv->bhtv', a_i, v_new))
        g_last = g_i[..., -1]
        k_dec = k_i * jnp.exp(g_last[..., None] - g_i)[..., None]
        state = state * jnp.exp(g_last)[..., None, None] + jnp.einsum('bhck,bhcv->bhkv', k_dec, v_new)
        return state, o_i

    s0 = jnp.zeros((b_, h_, dk, dv), jnp.float32)
    _, o = lax.scan(chunk_step, s0, (qc, kc, u_c, w_c, gcum, qk_intra))
    return o.transpose(1, 0, 3, 2, 4).reshape(b_, t_len, h_, dv)


def token_mix(h, w_in, conv_w, a_log, dt_bias, sm_w, sm_b, sm_ln_g, sm_ln_b, dn_norm_w, w_out):
    b_, t_len, _ = h.shape
    proj = h @ w_in
    splits = [GM_WIDTH, 2 * GM_WIDTH, 2 * GM_WIDTH + 3 * DN_WIDTH,
              2 * GM_WIDTH + 4 * DN_WIDTH, 2 * GM_WIDTH + 4 * DN_WIDTH + DN_HEADS]
    u_a, v_a, qkv, z, b_raw, a_raw = jnp.split(proj, splits, axis=-1)

    y_a = chunk_spatial_gating(u_a, v_a, sm_w, sm_b, sm_ln_g, sm_ln_b)

    qkv = jax.nn.silu(causal_short_conv(qkv, conv_w))
    q, k, v = jnp.split(qkv, 3, axis=-1)
    q = q.reshape(b_, t_len, DN_HEADS, DN_HEAD_DIM)
    k = k.reshape(b_, t_len, DN_HEADS, DN_HEAD_DIM)
    v = v.reshape(b_, t_len, DN_HEADS, DN_HEAD_DIM)
    beta = jax.nn.sigmoid(b_raw.astype(jnp.float32))
    g = -jnp.exp(a_log.astype(jnp.float32)) * jax.nn.softplus(a_raw.astype(jnp.float32) + dt_bias.astype(jnp.float32))
    o = gated_delta_rule(q, k, v, g, beta)
    zf = z.astype(jnp.float32).reshape(b_, t_len, DN_HEADS, DN_HEAD_DIM)
    o = rmsnorm(o, dn_norm_w) * jax.nn.silu(zf)
    y_b = o.reshape(b_, t_len, DN_WIDTH).astype(h.dtype)

    return jnp.concatenate([y_a, y_b], axis=-1) @ w_out


def cross_attend(h, mem_h, w_xq, w_xkv, w_xo):
    b_, t_len, _ = h.shape
    m_len = mem_h.shape[1]
    q = (h @ w_xq).reshape(b_, t_len, XA_HEADS, XA_HEAD_DIM)
    kv = (mem_h @ w_xkv).reshape(b_, m_len, 2, XA_HEADS, XA_HEAD_DIM)
    k, v = kv[:, :, 0], kv[:, :, 1]
    s = jnp.einsum('bthd,bmhd->bhtm', q, k).astype(jnp.float32) * (XA_HEAD_DIM ** -0.5)
    p = jax.nn.softmax(s, axis=-1).astype(v.dtype)
    o = jnp.einsum('bhtm,bmhd->bthd', p, v).reshape(b_, t_len, XA_HEADS * XA_HEAD_DIM)
    return o @ w_xo


def setup_inputs(seed: int = 0) -> dict:
    key = jax.random.key(seed)
    ks = iter(jax.random.split(key, 64))
    L = DEPTH

    def dense(shape, fan_in):
        return jax.random.normal(next(ks), shape, jnp.float32) * (fan_in ** -0.5)

    def gain(shape):
        return 1.0 + 0.05 * jax.random.normal(next(ks), shape, jnp.float32)

    def small(shape):
        return 0.02 * jax.random.normal(next(ks), shape, jnp.float32)

    x = jax.random.normal(next(ks), (BATCH, SEQ, D_MODEL), jnp.float32)
    mem = jax.random.normal(next(ks), (BATCH, N_MEM, D_MODEL), jnp.float32)
    a_log = jnp.log(jax.random.uniform(next(ks), (L, DN_HEADS), jnp.float32, minval=1.0, maxval=16.0))
    dt = jnp.exp(jax.random.uniform(next(ks), (L, DN_HEADS), jnp.float32,
                                    minval=float(np.log(1e-3)), maxval=float(np.log(1e-1))))
    dt_bias = dt + jnp.log(-jnp.expm1(-dt))
    return {
        "x": x,
        "mem": mem,
        "ffn1_norm_pre": gain((L, D_MODEL)),
        "ffn1_w_gate_up": dense((L, D_MODEL, 2 * D_FF), D_MODEL),
        "ffn1_w_down": dense((L, D_FF, D_MODEL), D_FF),
        "ffn1_norm_post": gain((L, D_MODEL)),
        "mix_norm_pre": gain((L, D_MODEL)),
        "w_in": dense((L, D_MODEL, IN_COLS), D_MODEL),
        "conv_w": dense((L, CONV_WIDTH, 3 * DN_WIDTH), CONV_WIDTH),
        "a_log": a_log,
        "dt_bias": dt_bias,
        "sm_w": dense((L, GM_HEADS, GM_CHUNK, GM_CHUNK), GM_CHUNK),
        "sm_b": gain((L, GM_HEADS, GM_CHUNK)),
        "sm_ln_g": gain((L, GM_WIDTH)),
        "sm_ln_b": small((L, GM_WIDTH)),
        "dn_norm_w": gain((L, DN_HEAD_DIM)),
        "w_out": dense((L, MIX_WIDTH, D_MODEL), MIX_WIDTH),
        "mix_norm_post": gain((L, D_MODEL)),
        "xa_norm_pre": gain((L, D_MODEL)),
        "mem_norm": gain((L, D_MODEL)),
        "w_xq": dense((L, D_MODEL, D_MODEL), D_MODEL),
        "w_xkv": dense((L, D_MODEL, 2 * D_MODEL), D_MODEL),
        "w_xo": dense((L, D_MODEL, D_MODEL), D_MODEL),
        "xa_norm_post": gain((L, D_MODEL)),
        "ffn2_norm_pre": gain((L, D_MODEL)),
        "ffn2_w_gate_up": dense((L, D_MODEL, 2 * D_FF), D_MODEL),
        "ffn2_w_down": dense((L, D_FF, D_MODEL), D_FF),
        "ffn2_norm_post": gain((L, D_MODEL)),
    }


def reference(x, mem, ffn1_norm_pre, ffn1_w_gate_up, ffn1_w_down, ffn1_norm_post,
              mix_norm_pre, w_in, conv_w, a_log, dt_bias, sm_w, sm_b, sm_ln_g, sm_ln_b,
              dn_norm_w, w_out, mix_norm_post, xa_norm_pre, mem_norm, w_xq, w_xkv, w_xo,
              xa_norm_post, ffn2_norm_pre, ffn2_w_gate_up, ffn2_w_down, ffn2_norm_post):
    for l in range(DEPTH):
        f = swiglu_ffn(rmsnorm(x, ffn1_norm_pre[l]), ffn1_w_gate_up[l], ffn1_w_down[l])
        x = x + 0.5 * rmsnorm(f, ffn1_norm_post[l])
        m = token_mix(rmsnorm(x, mix_norm_pre[l]), w_in[l], conv_w[l], a_log[l], dt_bias[l],
                      sm_w[l], sm_b[l], sm_ln_g[l], sm_ln_b[l], dn_norm_w[l], w_out[l])
        x = x + rmsnorm(m, mix_norm_post[l])
        c = cross_attend(rmsnorm(x, xa_norm_pre[l]), rmsnorm(mem, mem_norm[l]), w_xq[l], w_xkv[l], w_xo[l])
        x = x + rmsnorm(c, xa_norm_post[l])
        f = swiglu_ffn(rmsnorm(x, ffn2_norm_pre[l]), ffn2_w_gate_up[l], ffn2_w_down[l])
        x = x + 0.5 * rmsnorm(f, ffn2_norm_post[l])
    return x
```

```cpp
#include <hip/hip_runtime.h>
#include <hip/hip_cooperative_groups.h>
#include <cstdio>
namespace cg = cooperative_groups;
__device__ __forceinline__ int opaque_tid() { int t = threadIdx.x; asm volatile("" : "+v"(t)); return t; }
namespace pg8 {
#define PG8_LAS __attribute__((address_space(3)))
typedef unsigned short bf16_t;
typedef short bf16x8 __attribute__((ext_vector_type(8)));
typedef float f32x4 __attribute__((ext_vector_type(4)));
typedef unsigned u32x4 __attribute__((ext_vector_type(4)));
constexpr int BM = 256, BK = 64, HALF = 128, HTB = HALF * BK * 2  , STAGE_BYTES = 8 * HTB, NXCD = 8, WGM = 8;

__host__ __device__ __forceinline__ int lds_byte(int r, int c) { const int st = (r >> 4) * 2 + (c >> 5), rr = r & 15, cc = c & 31, ob = rr * 64 + cc * 2; return st * 1024 + (ob ^ (((ob >> 9) & 1) << 5)); }
__host__ __device__ __forceinline__ void stage_rc(int b, int& R, int& C) { const int st = b / 1024, sb = b % 1024, swz = sb ^ (((sb >> 9) & 1) << 5); R = (st >> 1) * 16 + swz / 64; C = (st & 1) * 32 + (swz % 64) / 2; }
__host__ __device__ __forceinline__ int perm32(int rho) { const int n = rho >> 4, i = rho & 15; return 8 * (i >> 2) + 4 * n + (i & 3); }

struct Unit { int pm, pn; };
struct Gemm { const bf16_t* A; const bf16_t* Bt; int M, N, K; };

struct StaticOrder {
    int nM, nN, nwg, G, c;
    __host__ __device__ void init(int M, int N, int G_, int c_) { nM = M / BM; nN = N / BM; nwg = nM * nN; G = G_; c = c_; }
    __host__ __device__ bool next(int i, Unit& u) const {
        const long L = (long)i * G + c; if (L >= nwg) return false;
        int wgid = (int)L; { const int q = nwg / NXCD, r = nwg % NXCD, xcd = wgid % NXCD, off = wgid / NXCD; wgid = (xcd < r ? xcd * (q + 1) : r * (q + 1) + (xcd - r) * q) + off; }
        const int nig = WGM * nN, gid = wgid / nig, fm = gid * WGM, gsz = (nM - fm) < WGM ? (nM - fm) : WGM;
        u.pm = fm + ((wgid % nig) % gsz); u.pn = (wgid % nig) / gsz; return true;
    }
    __device__ __forceinline__ void a_ready(const Unit&) const {}
    __device__ __forceinline__ void done(const Unit&) const {}
};
typedef __bf16 bf16v2_t __attribute__((ext_vector_type(2)));
typedef float f32x2_cv __attribute__((ext_vector_type(2)));
__device__ __forceinline__ unsigned cvt_pk_bf16(float lo, float hi) { const f32x2_cv v = {lo, hi}; return __builtin_bit_cast(unsigned, __builtin_convertvector(v, bf16v2_t)); }
typedef float f32x2 __attribute__((ext_vector_type(2)));
__device__ __forceinline__ f32x2 gelu_pk(f32x2 v) {
    const f32x2 av = __builtin_elementwise_abs(v), d = av * 0.2316418882f + 1.0f;
    f32x2 t; t.x = __builtin_amdgcn_rcpf(d.x); t.y = __builtin_amdgcn_rcpf(d.y);
    f32x2 q = t * 0.5307027145f + (-0.7265760135f); q = q * t + 0.7107068705f; q = q * t + (-0.142248368f); q = q * t + 0.127414796f; q = q * t;
    const f32x2 s = (v * v) * (-0.72134752044f);
    f32x2 e; e.x = __builtin_amdgcn_exp2f(s.x); e.y = __builtin_amdgcn_exp2f(s.y);
    const f32x2 m = v * (q * e), r = v - m;
    f32x2 o; o.x = v.x < 0.f ? m.x : r.x; o.y = v.y < 0.f ? m.y : r.y; return o;
}

struct EpiF32 {
    static constexpr bool PERM = false, AFTER_DRAIN = false;
    float* C; int ldc; const float* bias;
    __device__ __forceinline__ void operator()(const f32x4 (&acc)[2][2][4][2], const Unit& u, int wr, int wc, int fr, int fq) const {
        const int row0 = u.pm * BM + wr * 64 + fr, col0 = u.pn * BM + wc * 32 + 4 * fq;
        f32x4 bv[2][2];
#pragma unroll
        for (int bj = 0; bj < 2; ++bj)
#pragma unroll
            for (int n = 0; n < 2; ++n) bv[bj][n] = bias ? *(const f32x4*)(bias + col0 + bj * HALF + n * 16) : (f32x4){0.f, 0.f, 0.f, 0.f};
#pragma unroll
        for (int ai = 0; ai < 2; ++ai)
#pragma unroll
            for (int m = 0; m < 4; ++m) { float* rowp = C + (size_t)(row0 + ai * HALF + m * 16) * ldc + col0;
#pragma unroll
                for (int bj = 0; bj < 2; ++bj)
#pragma unroll
                    for (int n = 0; n < 2; ++n) *(f32x4*)(rowp + bj * HALF + n * 16) = acc[ai][bj][m][n] + bv[bj][n]; }
    }
};
typedef unsigned u32x2 __attribute__((ext_vector_type(2)));
__device__ __forceinline__ float silu_f(float g) { return g * __builtin_amdgcn_rcpf(1.0f + __expf(-g)); }
struct EpiSwiglu {
    static constexpr bool PERM = true, AFTER_DRAIN = false;
    bf16_t* O;
    __device__ __forceinline__ void operator()(const f32x4 (&acc)[2][2][4][2], const Unit& u, int wr, int wc, int fr, int fq) const {
        const int row0 = u.pm * BM + wr * 64 + fr, col0 = u.pn * HALF + wc * 32 + 8 * fq;
#pragma unroll
        for (int ai = 0; ai < 2; ++ai)
#pragma unroll
            for (int m = 0; m < 4; ++m) { bf16_t* rowp = O + (size_t)(row0 + ai * HALF + m * 16) * 5632 + col0;
                const f32x4 g0 = acc[ai][0][m][0], g1 = acc[ai][0][m][1], u0 = acc[ai][1][m][0], u1 = acc[ai][1][m][1];
                f32x4 v0, v1;
#pragma unroll
                for (int j = 0; j < 4; ++j) { v0[j] = silu_f(g0[j]) * u0[j]; v1[j] = silu_f(g1[j]) * u1[j]; }
                u32x4 w; w.x = cvt_pk_bf16(v0[0], v0[1]); w.y = cvt_pk_bf16(v0[2], v0[3]); w.z = cvt_pk_bf16(v1[0], v1[1]); w.w = cvt_pk_bf16(v1[2], v1[3]);
                *(u32x4*)rowp = w; }
    }
};
struct EpiIn {
    static constexpr bool PERM = true, AFTER_DRAIN = false;
    bf16_t* O; float* stats;
    __device__ __forceinline__ void operator()(const f32x4 (&acc)[2][2][4][2], const Unit& u, int wr, int wc, int fr, int fq) const {
        const int row0 = u.pm * BM + wr * 64 + fr, col0 = u.pn * BM + wc * 32 + 8 * fq;
        const int mode = u.pn < 4 ? 1 : (u.pn < 8 ? 2 : 0);
#pragma unroll
        for (int ai = 0; ai < 2; ++ai)
#pragma unroll
            for (int m = 0; m < 4; ++m) { const int row = row0 + ai * HALF + m * 16; bf16_t* rowp = O + (size_t)row * 6144 + col0; float s = 0.f, q = 0.f;
#pragma unroll
                for (int bj = 0; bj < 2; ++bj) { f32x4 v0 = acc[ai][bj][m][0], v1 = acc[ai][bj][m][1];
                    if (mode) { f32x2 a = gelu_pk((f32x2){v0[0], v0[1]}), b = gelu_pk((f32x2){v0[2], v0[3]}), c = gelu_pk((f32x2){v1[0], v1[1]}), d = gelu_pk((f32x2){v1[2], v1[3]});
                        v0 = (f32x4){a.x, a.y, b.x, b.y}; v1 = (f32x4){c.x, c.y, d.x, d.y}; }
                    if (mode == 2) {
#pragma unroll
                        for (int j = 0; j < 4; ++j) { s += v0[j] + v1[j]; q += v0[j] * v0[j] + v1[j] * v1[j]; } }
                    u32x4 w; w.x = cvt_pk_bf16(v0[0], v0[1]); w.y = cvt_pk_bf16(v0[2], v0[3]); w.z = cvt_pk_bf16(v1[0], v1[1]); w.w = cvt_pk_bf16(v1[2], v1[3]);
                    *(u32x4*)(rowp + bj * HALF) = w; }
                if (mode == 2) { s += __shfl_xor(s, 16); s += __shfl_xor(s, 32); q += __shfl_xor(q, 16); q += __shfl_xor(q, 32);
                    if (fq == 0) *(f32x2*)(stats + ((size_t)row * 16 + (u.pn - 4) * 4 + wc) * 2) = (f32x2){s, q}; } }
    }
};
struct EpiScaleBf16 {
    static constexpr bool PERM = true, AFTER_DRAIN = false;
    bf16_t* O; int ldc; float scale;
    __device__ __forceinline__ void operator()(const f32x4 (&acc)[2][2][4][2], const Unit& u, int wr, int wc, int fr, int fq) const {
        const int row0 = u.pm * BM + wr * 64 + fr, col0 = u.pn * BM + wc * 32 + 8 * fq;
#pragma unroll
        for (int ai = 0; ai < 2; ++ai)
#pragma unroll
            for (int m = 0; m < 4; ++m) { bf16_t* rowp = O + (size_t)(row0 + ai * HALF + m * 16) * ldc + col0;
#pragma unroll
                for (int bj = 0; bj < 2; ++bj) { const f32x4 v0 = acc[ai][bj][m][0] * scale, v1 = acc[ai][bj][m][1] * scale;
                    u32x4 w; w.x = cvt_pk_bf16(v0[0], v0[1]); w.y = cvt_pk_bf16(v0[2], v0[3]); w.z = cvt_pk_bf16(v1[0], v1[1]); w.w = cvt_pk_bf16(v1[2], v1[3]);
                    *(u32x4*)(rowp + bj * HALF) = w; } }
    }
};
struct EpiKV {
    static constexpr bool PERM = true, AFTER_DRAIN = false;
    bf16_t* Kb; bf16_t* Vt;
    __device__ __forceinline__ void operator()(const f32x4 (&acc)[2][2][4][2], const Unit& u, int wr, int wc, int fr, int fq) const {
        const int row0 = u.pm * BM + wr * 64 + fr, col0 = u.pn * BM + wc * 32 + 8 * fq;
#pragma unroll
        for (int ai = 0; ai < 2; ++ai)
#pragma unroll
            for (int m = 0; m < 4; ++m) { const int row = row0 + ai * HALF + m * 16;
#pragma unroll
                for (int bj = 0; bj < 2; ++bj) { const f32x4 v0 = acc[ai][bj][m][0], v1 = acc[ai][bj][m][1]; const int col = col0 + bj * HALF;
                    if (u.pn < 8) { u32x4 w; w.x = cvt_pk_bf16(v0[0], v0[1]); w.y = cvt_pk_bf16(v0[2], v0[3]); w.z = cvt_pk_bf16(v1[0], v1[1]); w.w = cvt_pk_bf16(v1[2], v1[3]);
                        *(u32x4*)(Kb + (size_t)row * 2048 + col) = w; }
                    else { const int cc = col - 2048, hh = cc >> 9, d = cc & 511, bb = row >> 8, mm = row & 255;
                        bf16_t* vp = Vt + ((size_t)((bb * 4 + hh) * 512 + d)) * 256 + mm;
#pragma unroll
                        for (int j = 0; j < 4; ++j) { vp[(size_t)j * 256] = (bf16_t)(cvt_pk_bf16(v0[j], 0.f) & 0xffffu); vp[(size_t)(4 + j) * 256] = (bf16_t)(cvt_pk_bf16(v1[j], 0.f) & 0xffffu); } } } }
    }
};
struct TailOrder {
    int G, c, off, n, nN;
    __device__ bool next(int i, Unit& u) const { if (i > 0) return false; const int idx = (G - 1 - c) - off; if (idx < 0 || idx >= n) return false; u.pm = idx / nN; u.pn = idx % nN; return true; }
    __device__ __forceinline__ void a_ready(const Unit&) const {}
    __device__ __forceinline__ void done(const Unit&) const {}
};
template <class Epi, class Sched, bool STAMP = false>
__device__ __forceinline__ void gemm_phase(PG8_LAS unsigned char* lds, const Gemm g, const Sched& S, const Epi& E, unsigned long long* stamps) {
    const int tid = opaque_tid(), wid = __builtin_amdgcn_readfirstlane(tid >> 6), lane = tid & 63, wr = wid >> 2, wc = wid & 3, fr = lane & 15, fq = lane >> 4;
    const int K = g.K, nt = K / BK;
    int ts_lo = 0, ts_hi = 0, nts = 0; const unsigned long long rt_entry = STAMP ? (unsigned long long)wall_clock64() : 0ull;
#define PG8_STAMP() do { if (STAMP && wid == 0 && nts < 64) { const unsigned long long _c = (unsigned long long)clock64(); \
        ts_lo = (lane == nts) ? (int)(unsigned)_c : ts_lo; ts_hi = (lane == nts) ? (int)(unsigned)(_c >> 32) : ts_hi; ++nts; } } while (0)
    PG8_STAMP();
    unsigned voffA[2], voffB[2];
#pragma unroll
    for (int i = 0; i < 2; ++i) { int R, C; stage_rc(tid * 16 + i * 8192, R, C); const int Rb = Epi::PERM ? ((R & ~31) + perm32(R & 31)) : R;
        voffA[i] = (unsigned)(R * K + C) * 2u; voffB[i] = (unsigned)(Rb * K + C) * 2u; }
    const size_t kstep = (size_t)(BK * 2);
    const size_t hstep = (size_t)HALF * K * 2;
    const size_t tstep = 2 * hstep;
    const unsigned ldsw = (unsigned)wid * 1024u;
    const int aoff = lds_byte(wr * 64 + fr, fq * 8), boff = lds_byte(wc * 32 + fr, fq * 8);
#define PG8_SA(b, h) (((b) * 2 + (h)) * HTB)
#define PG8_SB(b, h) ((4 + (b) * 2 + (h)) * HTB)
#define PG8_STAGE(bufoff, gbase, voff) do { _Pragma("unroll") for (int _i = 0; _i < 2; ++_i) \
        __builtin_amdgcn_global_load_lds((const unsigned*)((const char*)(gbase) + (voff)[_i]), (PG8_LAS unsigned*)(lds + (bufoff) + ldsw + _i * 8192), 16, 0, 0); } while (0)
#define PG8_LDA(dst, b, h) do { _Pragma("unroll") for (int m = 0; m < 4; ++m) _Pragma("unroll") for (int k = 0; k < 2; ++k) dst[m][k] = *(const PG8_LAS bf16x8*)(lds + PG8_SA(b, h) + aoff + m * 2048 + k * 1024); } while (0)
#define PG8_LDB(dst, b, h) do { _Pragma("unroll") for (int n = 0; n < 2; ++n) _Pragma("unroll") for (int k = 0; k < 2; ++k) dst[n][k] = *(const PG8_LAS bf16x8*)(lds + PG8_SB(b, h) + boff + n * 2048 + k * 1024); } while (0)
#define PG8_MMA(ai, bj, At, Bt) do { __builtin_amdgcn_s_setprio(1); _Pragma("unroll") for (int m = 0; m < 4; ++m) _Pragma("unroll") for (int n = 0; n < 2; ++n) _Pragma("unroll") for (int k = 0; k < 2; ++k) \
        acc[ai][bj][m][n] = __builtin_amdgcn_mfma_f32_16x16x32_bf16(Bt[n][k], At[m][k], acc[ai][bj][m][n], 0, 0, 0); __builtin_amdgcn_s_setprio(0); } while (0)
#define PG8_WAIT_V(n) asm volatile("s_waitcnt vmcnt(" #n ")" ::: "memory")
#define PG8_WAIT_L(n) asm volatile("s_waitcnt lgkmcnt(" #n ")" ::: "memory")
#define PG8_BAR __builtin_amdgcn_s_barrier()
#define PG8_SCHED __builtin_amdgcn_sched_barrier(0)
    Unit cur, nxt; int ui = 0;
    if (!S.next(0, cur)) return;
    f32x4 acc[2][2][4][2];
#pragma unroll
    for (int a = 0; a < 2; ++a)
#pragma unroll
        for (int b = 0; b < 2; ++b)
#pragma unroll
            for (int m = 0; m < 4; ++m)
#pragma unroll
                for (int n = 0; n < 2; ++n) acc[a][b][m][n] = (f32x4){0.f, 0.f, 0.f, 0.f};
    bf16x8 At[4][2], B0[2][2], B1[2][2];
    const char* cA = (const char*)g.A + (size_t)cur.pm * tstep; const char* cB = (const char*)g.Bt + (size_t)cur.pn * tstep;
    S.a_ready(cur);
    PG8_STAGE(PG8_SB(0, 0), cB, voffB); PG8_STAGE(PG8_SA(0, 0), cA, voffA); PG8_STAGE(PG8_SB(0, 1), cB + hstep, voffB); PG8_STAGE(PG8_SA(0, 1), cA + hstep, voffA);
    if (wr == 1) PG8_BAR;
    PG8_WAIT_V(4); PG8_BAR;
    PG8_STAGE(PG8_SB(1, 0), cB + kstep, voffB); PG8_STAGE(PG8_SA(1, 0), cA + kstep, voffA); PG8_STAGE(PG8_SB(1, 1), cB + hstep + kstep, voffB);
    PG8_WAIT_V(6); PG8_BAR;
    PG8_STAMP();
    for (;;) {
        const bool has_next = S.next(ui + 1, nxt);
        const char* nA = has_next ? (const char*)g.A + (size_t)nxt.pm * tstep : cA; const char* nB = has_next ? (const char*)g.Bt + (size_t)nxt.pn * tstep : cB;
        for (int t = 0; t < nt; t += 2) {
            const bool last = (t == nt - 2);
            const char* a1 = cA + (size_t)(t + 1) * kstep;
            const char* a2 = last ? nA : cA + (size_t)(t + 2) * kstep; const char* b2 = last ? nB : cB + (size_t)(t + 2) * kstep;
            const char* a3 = a2 + kstep; const char* b3 = b2 + kstep;
            if (last && has_next) S.a_ready(nxt);
            PG8_LDB(B0, 0, 0); PG8_SCHED; PG8_LDA(At, 0, 0); PG8_STAGE(PG8_SA(1, 1), a1 + hstep, voffA);
            PG8_WAIT_L(8); PG8_BAR; PG8_WAIT_L(0); PG8_MMA(0, 0, At, B0); PG8_BAR; PG8_SCHED;
            PG8_LDB(B1, 0, 1); PG8_STAGE(PG8_SB(0, 0), b2, voffB);
            PG8_BAR; PG8_WAIT_L(0); PG8_MMA(0, 1, At, B1); PG8_BAR;
            PG8_LDA(At, 0, 1); PG8_STAGE(PG8_SA(0, 0), a2, voffA);
            PG8_BAR; PG8_WAIT_L(0); PG8_MMA(1, 0, At, B0); PG8_BAR; PG8_SCHED;
            PG8_STAGE(PG8_SB(0, 1), b2 + hstep, voffB);
            PG8_WAIT_V(6); PG8_BAR; PG8_MMA(1, 1, At, B1); PG8_BAR;
            PG8_LDB(B0, 1, 0); PG8_SCHED; PG8_LDA(At, 1, 0); PG8_STAGE(PG8_SA(0, 1), a2 + hstep, voffA);
            PG8_WAIT_L(8); PG8_BAR; PG8_WAIT_L(0); PG8_MMA(0, 0, At, B0); PG8_BAR; PG8_SCHED;
            PG8_LDB(B1, 1, 1); PG8_STAGE(PG8_SB(1, 0), b3, voffB);
            PG8_BAR; PG8_WAIT_L(0); PG8_MMA(0, 1, At, B1); PG8_BAR;
            PG8_LDA(At, 1, 1); PG8_STAGE(PG8_SA(1, 0), a3, voffA);
            PG8_BAR; PG8_WAIT_L(0); PG8_MMA(1, 0, At, B0); PG8_BAR; PG8_SCHED;
            PG8_STAGE(PG8_SB(1, 1), b3 + hstep, voffB);
            PG8_WAIT_V(6); PG8_BAR; PG8_MMA(1, 1, At, B1); PG8_BAR;
        }
        PG8_STAMP();
        if constexpr (!Epi::AFTER_DRAIN) { E(acc, cur, wr, wc, fr, fq); S.done(cur); }
        PG8_STAMP();
        if (!has_next) break;
#pragma unroll
        for (int a = 0; a < 2; ++a)
#pragma unroll
            for (int b = 0; b < 2; ++b)
#pragma unroll
                for (int m = 0; m < 4; ++m)
#pragma unroll
                    for (int n = 0; n < 2; ++n) acc[a][b][m][n] = (f32x4){0.f, 0.f, 0.f, 0.f};
        cur = nxt; cA = nA; cB = nB; ++ui;
    }
    PG8_WAIT_V(0);
    if (wr == 0) PG8_BAR;
    PG8_BAR;
    if constexpr (Epi::AFTER_DRAIN) { E.fused(acc, cur, wr, wc, fr, fq, lds, wid, lane); S.done(cur); }
    PG8_STAMP();
    if (STAMP && wid == 0) { stamps[lane] = lane < nts ? (((unsigned long long)(unsigned)ts_hi << 32) | (unsigned)ts_lo) : 0ull;
        if (lane == 62) stamps[62] = rt_entry; if (lane == 63) stamps[63] = (unsigned long long)wall_clock64(); }
#undef PG8_STAMP
#undef PG8_SA
#undef PG8_SB
#undef PG8_STAGE
#undef PG8_LDA
#undef PG8_LDB
#undef PG8_MMA
#undef PG8_WAIT_V
#undef PG8_WAIT_L
#undef PG8_BAR
#undef PG8_SCHED
}
}
using pg8::silu_f; using pg8::bf16_t; using pg8::bf16x8; using pg8::f32x4; using pg8::f32x2; using pg8::u32x4; using pg8::u32x2; using pg8::cvt_pk_bf16;
#define LAS __attribute__((address_space(3)))
constexpr int T_ = 8192, D_ = 2048, FF_ = 5632;
constexpr int LDS_BYTES = 136 * 1024;
constexpr float EPS = 1e-6f;
constexpr size_t SZ_WGU = (size_t)11264 * 2048 * 2, SZ_WD = (size_t)2048 * 5632 * 2, SZ_WIN = (size_t)6144 * 2048 * 2, SZ_WSQ = (size_t)2048 * 2048 * 2, SZ_WKV = (size_t)4096 * 2048 * 2, SZ_WBA = (size_t)16 * 2048 * 2;
constexpr size_t OFF_WGU = 0;
constexpr size_t OFF_WD = OFF_WGU + 4 * SZ_WGU;
constexpr size_t OFF_WIN = OFF_WD + 4 * SZ_WD;
constexpr size_t OFF_WOUT = OFF_WIN + 2 * SZ_WIN;
constexpr size_t OFF_WXQ = OFF_WOUT + 2 * SZ_WSQ;
constexpr size_t OFF_WXO = OFF_WXQ + 2 * SZ_WSQ;
constexpr size_t OFF_WKV = OFF_WXO + 2 * SZ_WSQ;
constexpr size_t OFF_WBA = OFF_WKV + 2 * SZ_WKV;
constexpr size_t OFF_H = OFF_WBA + 2 * SZ_WBA;
constexpr size_t OFF_MEMH = OFF_H + (size_t)T_ * D_ * 2;
constexpr size_t OFF_BIG = OFF_MEMH + (size_t)2 * 1024 * 2048 * 2;
constexpr size_t OFF_F = OFF_BIG + (size_t)T_ * 6144 * 2;
constexpr size_t OFF_Y = OFF_F + (size_t)T_ * D_ * 4;
constexpr size_t OFF_AO = OFF_Y + (size_t)T_ * D_ * 2;
constexpr size_t OFF_KB = OFF_AO + (size_t)T_ * D_ * 2;
constexpr size_t OFF_VT = OFF_KB + (size_t)2 * 1024 * 2048 * 2;
constexpr size_t OFF_DW = OFF_VT + (size_t)2 * 1024 * 2048 * 2;
constexpr size_t OFF_DU = OFF_DW + (size_t)1024 * 64 * 128 * 2;
constexpr size_t OFF_DQG = OFF_DU + (size_t)1024 * 64 * 128 * 4;
constexpr size_t OFF_DKT = OFF_DQG + (size_t)1024 * 64 * 128 * 2;
constexpr size_t OFF_DA = OFF_DKT + (size_t)1024 * 64 * 128 * 2;
constexpr size_t OFF_DEG = OFF_DA + (size_t)1024 * 64 * 64 * 2;
constexpr size_t OFF_BG = OFF_DEG + 4096;
constexpr size_t OFF_STATS = OFF_BG + (size_t)T_ * 16 * 4;
constexpr size_t WS_END = OFF_STATS + (size_t)2 * T_ * 32 * 4;

struct P { const float* in[28]; float* out; unsigned char* ws; };

__device__ __forceinline__ float bf2f(unsigned v) { return __uint_as_float(v << 16); }
__device__ __forceinline__ unsigned pk2(float a, float b) { return pg8::cvt_pk_bf16(a, b); }
__device__ __forceinline__ float wave_sum(float v) {
#pragma unroll
    for (int o = 32; o >= 1; o >>= 1) v += __shfl_xor(v, o);
    return v; }
__device__ __forceinline__ bf16x8 mk8(unsigned a, unsigned b, unsigned c, unsigned d) { u32x4 w; w.x = a; w.y = b; w.z = c; w.w = d; return __builtin_bit_cast(bf16x8, w); }
#define MFMA16(a, b, c) __builtin_amdgcn_mfma_f32_16x16x32_bf16((a), (b), (c), 0, 0, 0)
#define MFMA4F(a, b, c) __builtin_amdgcn_mfma_f32_16x16x4f32((a), (b), (c), 0, 0, 0)

__device__ __forceinline__ void rowpass(int nrows, const float* f, const float* gpost, float scale, const float* xin, float* xout, const float* gpre, bf16_t* h) {
    const int tid_ = opaque_tid(); const int lane = tid_ & 63, wv = tid_ >> 6;
    const int gw = blockIdx.x * 8 + wv, nw = gridDim.x * 8;
    for (int r = gw; r < nrows; r += nw) {
        const size_t base = (size_t)r * 2048 + lane * 4;
        f32x4 xv[8];
#pragma unroll
        for (int i = 0; i < 8; ++i) xv[i] = *(const f32x4*)(xin + base + i * 256);
        if (f) {
            f32x4 fv[8]; float ss = 0.f;
#pragma unroll
            for (int i = 0; i < 8; ++i) { fv[i] = *(const f32x4*)(f + base + i * 256); ss += fv[i].x * fv[i].x + fv[i].y * fv[i].y + fv[i].z * fv[i].z + fv[i].w * fv[i].w; }
            ss = wave_sum(ss);
            const float rs = rsqrtf(ss * (1.0f / 2048.0f) + EPS) * scale;
#pragma unroll
            for (int i = 0; i < 8; ++i) { const f32x4 g = *(const f32x4*)(gpost + lane * 4 + i * 256); xv[i] += fv[i] * rs * g; }
        }
        if (xout) {
#pragma unroll
            for (int i = 0; i < 8; ++i) *(f32x4*)(xout + base + i * 256) = xv[i];
        }
        if (h) {
            float ss = 0.f;
#pragma unroll
            for (int i = 0; i < 8; ++i) ss += xv[i].x * xv[i].x + xv[i].y * xv[i].y + xv[i].z * xv[i].z + xv[i].w * xv[i].w;
            ss = wave_sum(ss);
            const float rs = rsqrtf(ss * (1.0f / 2048.0f) + EPS);
#pragma unroll
            for (int i = 0; i < 8; ++i) { const f32x4 g = *(const f32x4*)(gpre + lane * 4 + i * 256); const f32x4 o = xv[i] * rs * g;
                u32x2 w; w.x = pk2(o.x, o.y); w.y = pk2(o.z, o.w); *(u32x2*)(h + base + i * 256) = w; }
        }
    }
}

struct ConvJob { const float* W; bf16_t* Wt; int ldw, K, k0, n0, sc0; };
__device__ __forceinline__ ConvJob conv_decode(const P& p, int g) {
    const int l = g / 12544; int r = g - l * 12544; ConvJob j; int tilesN; bool il = false;
    if (r < 2816) { j.W = p.in[3] + (size_t)l * 2048 * 11264; j.ldw = 11264; j.K = 2048; j.Wt = (bf16_t*)(p.ws + OFF_WGU + (size_t)(0 * 2 + l) * SZ_WGU); tilesN = 176; il = true; }
    else if (r < 4224) { r -= 2816; j.W = p.in[4] + (size_t)l * 5632 * 2048; j.ldw = 2048; j.K = 5632; j.Wt = (bf16_t*)(p.ws + OFF_WD + (size_t)(0 * 2 + l) * SZ_WD); tilesN = 32; }
    else if (r < 5760) { r -= 4224; j.W = p.in[7] + (size_t)l * 2048 * 6160; j.ldw = 6160; j.K = 2048; j.Wt = (bf16_t*)(p.ws + OFF_WIN + (size_t)l * SZ_WIN); tilesN = 96; }
    else if (r < 6272) { r -= 5760; j.W = p.in[16] + (size_t)l * 2048 * 2048; j.ldw = 2048; j.K = 2048; j.Wt = (bf16_t*)(p.ws + OFF_WOUT + (size_t)l * SZ_WSQ); tilesN = 32; }
    else if (r < 6784) { r -= 6272; j.W = p.in[20] + (size_t)l * 2048 * 2048; j.ldw = 2048; j.K = 2048; j.Wt = (bf16_t*)(p.ws + OFF_WXQ + (size_t)l * SZ_WSQ); tilesN = 32; }
    else if (r < 7808) { r -= 6784; j.W = p.in[21] + (size_t)l * 2048 * 4096; j.ldw = 4096; j.K = 2048; j.Wt = (bf16_t*)(p.ws + OFF_WKV + (size_t)l * SZ_WKV); tilesN = 64; }
    else if (r < 8320) { r -= 7808; j.W = p.in[22] + (size_t)l * 2048 * 2048; j.ldw = 2048; j.K = 2048; j.Wt = (bf16_t*)(p.ws + OFF_WXO + (size_t)l * SZ_WSQ); tilesN = 32; }
    else if (r < 11136) { r -= 8320; j.W = p.in[25] + (size_t)l * 2048 * 11264; j.ldw = 11264; j.K = 2048; j.Wt = (bf16_t*)(p.ws + OFF_WGU + (size_t)(1 * 2 + l) * SZ_WGU); tilesN = 176; il = true; }
    else { r -= 11136; j.W = p.in[26] + (size_t)l * 5632 * 2048; j.ldw = 2048; j.K = 5632; j.Wt = (bf16_t*)(p.ws + OFF_WD + (size_t)(1 * 2 + l) * SZ_WD); tilesN = 32; }
    const int kt = r / tilesN, nt = r - kt * tilesN; j.k0 = kt * 128; j.n0 = nt * 64;
    j.sc0 = il ? (((j.n0 >> 7) & 1) * 5632 + (j.n0 >> 8) * 128 + (j.n0 & 127)) : j.n0;
    return j;
}
__device__ __forceinline__ void phase0(LAS unsigned char* lds, const P& p) {
    const int tid = opaque_tid();
    LAS float* tl = (LAS float*)lds;
    const int c4 = (tid & 15) * 4, kr = tid >> 4;
    const int kg = tid & 15, nr = tid >> 4;
    constexpr int TOTAL = 2 * 12544;
    int g = blockIdx.x;
    f32x4 v[4]; ConvJob j;
    if (g < TOTAL) { j = conv_decode(p, g);
#pragma unroll
        for (int i = 0; i < 4; ++i) v[i] = *(const f32x4*)(j.W + (size_t)(j.k0 + kr + 32 * i) * j.ldw + j.sc0 + c4); }
    while (g < TOTAL) {
#pragma unroll
        for (int i = 0; i < 4; ++i) { const int k = kr + 32 * i; tl[(c4 + 0) * 129 + k] = v[i].x; tl[(c4 + 1) * 129 + k] = v[i].y; tl[(c4 + 2) * 129 + k] = v[i].z; tl[(c4 + 3) * 129 + k] = v[i].w; }
        __syncthreads();
        const ConvJob cj = j; const int gn = g + gridDim.x;
        if (gn < TOTAL) { j = conv_decode(p, gn);
#pragma unroll
            for (int i = 0; i < 4; ++i) v[i] = *(const f32x4*)(j.W + (size_t)(j.k0 + kr + 32 * i) * j.ldw + j.sc0 + c4); }
#pragma unroll
        for (int i = 0; i < 2; ++i) { const int n = nr + 32 * i; const LAS float* s = tl + n * 129 + kg * 8;
            u32x4 w; w.x = pk2(s[0], s[1]); w.y = pk2(s[2], s[3]); w.z = pk2(s[4], s[5]); w.w = pk2(s[6], s[7]);
            *(u32x4*)(cj.Wt + (size_t)(cj.n0 + n) * cj.K + cj.k0 + kg * 8) = w; }
        __syncthreads();
        g = gn;
    }
    { const int gt = blockIdx.x * 512 + tid, gn = gridDim.x * 512;
      for (int e = gt; e < 2 * 16 * 2048; e += gn) { const int l = e >> 15, n = (e >> 11) & 15, k = e & 2047;
          ((bf16_t*)(p.ws + OFF_WBA))[e] = (bf16_t)(pk2(p.in[7][((size_t)l * 2048 + k) * 6160 + 6144 + n], 0.f) & 0xffffu); }
    }
    rowpass(T_, nullptr, nullptr, 0.f, p.in[0], p.out, p.in[2], (bf16_t*)(p.ws + OFF_H));
    rowpass(1024, nullptr, nullptr, 0.f, p.in[1], nullptr, p.in[19], (bf16_t*)(p.ws + OFF_MEMH));
    rowpass(1024, nullptr, nullptr, 0.f, p.in[1], nullptr, p.in[19] + 2048, (bf16_t*)(p.ws + OFF_MEMH) + (size_t)1024 * 2048);
}

__device__ __forceinline__ void wy_unit(LAS unsigned char* lds, const P& p, int l, int uid) {
    const int tid = opaque_tid(), lane = tid & 63, wv = tid >> 6;
    const int bh = uid >> 5, n = uid & 31, b = bh >> 3, hh = bh & 7;
    const int t0 = b * 2048 + n * 64;
    LAS float* sq = (LAS float*)lds; LAS float* sk = sq + 64 * 132; LAS float* sv = sk + 64 * 132; LAS float* sL = sv + 64 * 132;
    LAS float* sgc = sL + 64 * 64; LAS float* sbeta = sgc + 64; LAS float* segc = sbeta + 64;
    const bf16_t* proj = (const bf16_t*)(p.ws + OFF_BIG);
    const float* cw = p.in[8] + (size_t)l * 4 * 3072;
    bf16_t* DW = (bf16_t*)(p.ws + OFF_DW); float* DU = (float*)(p.ws + OFF_DU); bf16_t* DQG = (bf16_t*)(p.ws + OFF_DQG);
    bf16_t* DKT = (bf16_t*)(p.ws + OFF_DKT); bf16_t* DA = (bf16_t*)(p.ws + OFF_DA); float* DEG = (float*)(p.ws + OFF_DEG);
    {
        const int d = tid & 127, tb = (tid >> 7) * 16; const int tseq = n * 64 + tb;
#pragma unroll
        for (int which = 0; which < 3; ++which) {
            const int ch = which * 1024 + hh * 128 + d;
            const float w0 = cw[ch], w1 = cw[3072 + ch], w2 = cw[2 * 3072 + ch], w3 = cw[3 * 3072 + ch];
            const bf16_t* src = proj + (size_t)(t0 + tb) * 6144 + 2048 + ch;
            float x0 = tseq >= 3 ? bf2f(*(src - 3 * 6144)) : 0.f, x1 = tseq >= 2 ? bf2f(*(src - 2 * 6144)) : 0.f, x2 = tseq >= 1 ? bf2f(*(src - 6144)) : 0.f;
            LAS float* dst = (which == 0 ? sq : (which == 1 ? sk : sv)) + tb * 132 + d;
#pragma unroll 4
            for (int i = 0; i < 16; ++i) { const float x3 = bf2f(src[(size_t)i * 6144]); float y = w0 * x0 + w1 * x1 + w2 * x2 + w3 * x3; y = silu_f(y); dst[i * 132] = y; x0 = x1; x1 = x2; x2 = x3; }
        }
    }
    if (wv == 0) {
        const float* bg = (const float*)(p.ws + OFF_BG) + (size_t)(t0 + lane) * 16;
        const float beta = bg[hh]; float g = bg[8 + hh];
#pragma unroll
        for (int o = 1; o < 64; o <<= 1) { const float t = __shfl_up(g, o); if (lane >= o) g += t; }
        sgc[lane] = g; sbeta[lane] = beta; segc[lane] = __expf(g);
    }
    __syncthreads();
    for (int i = 0; i < 8; ++i) { const int t = wv * 8 + i;
        { const float a0 = sq[t * 132 + lane], a1 = sq[t * 132 + 64 + lane]; const float r = rsqrtf(wave_sum(a0 * a0 + a1 * a1) + EPS) * 0.08838834764831845f; sq[t * 132 + lane] = a0 * r; sq[t * 132 + 64 + lane] = a1 * r; }
        { const float a0 = sk[t * 132 + lane], a1 = sk[t * 132 + 64 + lane]; const float r = rsqrtf(wave_sum(a0 * a0 + a1 * a1) + EPS); sk[t * 132 + lane] = a0 * r; sk[t * 132 + 64 + lane] = a1 * r; }
    }
    __syncthreads();
    {
        const int ti = wv >> 1, sp = wv & 1, r16 = lane & 15, g4 = lane >> 4;
        f32x4 akk0 = {0.f, 0.f, 0.f, 0.f}, akk1 = akk0, aqk0 = akk0, aqk1 = akk0;
        if (2 * sp <= ti) {
#pragma unroll 2
            for (int st = 0; st < 8; ++st) { const int dofs = st * 16 + g4 * 4;
                const f32x4 kt = *(const LAS f32x4*)(sk + (16 * ti + r16) * 132 + dofs), qt = *(const LAS f32x4*)(sq + (16 * ti + r16) * 132 + dofs);
                const f32x4 ks0 = *(const LAS f32x4*)(sk + (32 * sp + r16) * 132 + dofs), ks1 = *(const LAS f32x4*)(sk + (32 * sp + 16 + r16) * 132 + dofs);
#pragma unroll
                for (int c = 0; c < 4; ++c) { akk0 = MFMA4F(kt[c], ks0[c], akk0); aqk0 = MFMA4F(qt[c], ks0[c], aqk0); akk1 = MFMA4F(kt[c], ks1[c], akk1); aqk1 = MFMA4F(qt[c], ks1[c], aqk1); } }
        }
#pragma unroll
        for (int e = 0; e < 2; ++e) { const f32x4 akk = e ? akk1 : akk0, aqk = e ? aqk1 : aqk0; const int s = 32 * sp + 16 * e + r16; const float gs = sgc[s];
#pragma unroll
            for (int r = 0; r < 4; ++r) { const int t = 16 * ti + 4 * g4 + r; const float dec = (s <= t) ? __expf(fminf(sgc[t] - gs, 0.f)) : 0.f;
                sL[t * 64 + s] = (s < t) ? sbeta[t] * akk[r] * dec : 0.f;
                DA[((size_t)uid * 64 + t) * 64 + s] = (bf16_t)(pk2(aqk[r] * dec, 0.f) & 0xffffu); } }
    }
    __syncthreads();
    {
        { const int d2 = (tid & 63) * 2, tr = tid >> 6;
#pragma unroll 4
          for (int i = 0; i < 8; ++i) { const int t = tr + 8 * i; const float e = segc[t]; const f32x2 qv = *(const LAS f32x2*)(sq + t * 132 + d2); *(unsigned*)(DQG + ((size_t)uid * 64 + t) * 128 + d2) = pk2(qv.x * e, qv.y * e); } }
        { const int t2 = (tid & 31) * 2, dr = tid >> 5; const float gl = sgc[63]; const float e0 = __expf(gl - sgc[t2]), e1 = __expf(gl - sgc[t2 + 1]);
#pragma unroll 4
          for (int i = 0; i < 8; ++i) { const int d = dr + 16 * i; *(unsigned*)(DKT + ((size_t)uid * 128 + d) * 64 + t2) = pk2(sk[t2 * 132 + d] * e0, sk[(t2 + 1) * 132 + d] * e1); } }
        if (tid == 0) DEG[uid] = segc[63];
    }
    __syncthreads();
    if (tid < 256) {
        const bool isu = tid < 128; LAS float* col = isu ? (sv + tid) : (sk + (tid - 128));
#pragma unroll 1
        for (int bi = 0; bi < 4; ++bi) {
            float a[16];
#pragma unroll
            for (int r = 0; r < 16; ++r) { const int t = 16 * bi + r; a[r] = col[t * 132] * sbeta[t] * (isu ? 1.0f : segc[t]); }
            const LAS float* Lb = sL + (16 * bi) * 64;
#pragma unroll 1
            for (int sg = 0; sg < 4 * bi; ++sg) {
                const float s0 = col[(4 * sg + 0) * 132], s1 = col[(4 * sg + 1) * 132], s2 = col[(4 * sg + 2) * 132], s3 = col[(4 * sg + 3) * 132];
#pragma unroll
                for (int r = 0; r < 16; ++r) { const f32x4 lv = *(const LAS f32x4*)(Lb + r * 64 + 4 * sg); a[r] -= lv.x * s0 + lv.y * s1 + lv.z * s2 + lv.w * s3; }
            }
#pragma unroll
            for (int r = 1; r < 16; ++r) {
#pragma unroll
                for (int j = 0; j < (r + 3) / 4; ++j) { const f32x4 lv = *(const LAS f32x4*)(Lb + r * 64 + 16 * bi + 4 * j);
                    if (4 * j + 0 < r) a[r] -= lv.x * a[4 * j + 0]; if (4 * j + 1 < r) a[r] -= lv.y * a[4 * j + 1]; if (4 * j + 2 < r) a[r] -= lv.z * a[4 * j + 2]; if (4 * j + 3 < r) a[r] -= lv.w * a[4 * j + 3]; }
            }
#pragma unroll
            for (int r = 0; r < 16; ++r) col[(16 * bi + r) * 132] = a[r];
        }
    }
    __syncthreads();
    {
        const int d2 = (tid & 63) * 2, tr = tid >> 6;
#pragma unroll 4
        for (int i = 0; i < 8; ++i) { const int t = tr + 8 * i;
            *(f32x2*)(DU + ((size_t)uid * 64 + t) * 128 + d2) = *(const LAS f32x2*)(sv + t * 132 + d2);
            const f32x2 wv2 = *(const LAS f32x2*)(sk + t * 132 + d2); *(unsigned*)(DW + ((size_t)uid * 64 + t) * 128 + d2) = pk2(wv2.x, wv2.y); }
    }
    __syncthreads();
}

__device__ __forceinline__ void sgu_unit(LAS unsigned char* lds, const P& p, int l, int uid) {
    const int tid = opaque_tid(), lane = tid & 63, wv = tid >> 6, r16 = lane & 15, g4 = lane >> 4;
    const int hh = uid & 7, t0 = (uid >> 3) * 128;
    LAS bf16_t* vT = (LAS bf16_t*)lds;
    const bf16_t* proj = (const bf16_t*)(p.ws + OFF_BIG);
    const float* stats = (const float*)(p.ws + OFF_STATS) + (size_t)l * T_ * 32;
    const float* lng = p.in[13] + l * 1024 + hh * 128; const float* lnb = p.in[14] + l * 1024 + hh * 128;
    {
        const int s = tid & 127, dgb = tid >> 7;
        float su = 0.f, sqq = 0.f;
#pragma unroll
        for (int i = 0; i < 8; ++i) { const f32x4 pv = *(const f32x4*)(stats + (size_t)(t0 + s) * 32 + 4 * i); su += pv.x + pv.z; sqq += pv.y + pv.w; }
        const float mu = su * (1.0f / 1024.0f); const float var = fmaxf(sqq * (1.0f / 1024.0f) - mu * mu, 0.f); const float rs = rsqrtf(var + EPS);
#pragma unroll
        for (int i = 0; i < 4; ++i) { const int dg = dgb + 4 * i;
            const u32x4 raw = *(const u32x4*)(proj + (size_t)(t0 + s) * 6144 + 1024 + hh * 128 + dg * 8);
            const f32x4 ga = *(const f32x4*)(lng + dg * 8), gb = *(const f32x4*)(lng + dg * 8 + 4), ba = *(const f32x4*)(lnb + dg * 8), bb = *(const f32x4*)(lnb + dg * 8 + 4);
            float vv[8] = {bf2f(raw.x & 0xffffu), bf2f(raw.x >> 16), bf2f(raw.y & 0xffffu), bf2f(raw.y >> 16), bf2f(raw.z & 0xffffu), bf2f(raw.z >> 16), bf2f(raw.w & 0xffffu), bf2f(raw.w >> 16)};
            const float gg[8] = {ga.x, ga.y, ga.z, ga.w, gb.x, gb.y, gb.z, gb.w}, bbv[8] = {ba.x, ba.y, ba.z, ba.w, bb.x, bb.y, bb.z, bb.w};
#pragma unroll
            for (int e = 0; e < 8; ++e) vT[(dg * 8 + e) * 136 + s] = (bf16_t)(pk2((vv[e] - mu) * rs * gg[e] + bbv[e], 0.f) & 0xffffu); }
    }
    __syncthreads();
    const int t = 16 * wv + r16;
    const float* wm = p.in[11] + (((size_t)l * 8 + hh) * 128 + t) * 128;
    const int nkk = (16 * wv + 15) / 32 + 1;
    f32x4 acc[8];
#pragma unroll
    for (int i = 0; i < 8; ++i) acc[i] = (f32x4){0.f, 0.f, 0.f, 0.f};
    for (int kk = 0; kk < nkk; ++kk) { const int s0 = 32 * kk + 8 * g4;
        f32x4 w0 = *(const f32x4*)(wm + s0), w1 = *(const f32x4*)(wm + s0 + 4);
#pragma unroll
        for (int c = 0; c < 4; ++c) { if (s0 + c > t) w0[c] = 0.f; if (s0 + 4 + c > t) w1[c] = 0.f; }
        const bf16x8 af = mk8(pk2(w0.x, w0.y), pk2(w0.z, w0.w), pk2(w1.x, w1.y), pk2(w1.z, w1.w));
#pragma unroll
        for (int nt = 0; nt < 8; ++nt) { const bf16x8 bfr = *(const LAS bf16x8*)(vT + (16 * nt + r16) * 136 + s0); acc[nt] = MFMA16(bfr, af, acc[nt]); } }
    const float bias = p.in[12][((size_t)l * 8 + hh) * 128 + t];
    const bf16_t* gu = proj + (size_t)(t0 + t) * 6144 + hh * 128; bf16_t* yo = (bf16_t*)(p.ws + OFF_Y) + (size_t)(t0 + t) * 2048 + hh * 128;
#pragma unroll
    for (int nt = 0; nt < 8; ++nt) { const int d = 16 * nt + 4 * g4; const u32x2 gr = *(const u32x2*)(gu + d);
        u32x2 w; w.x = pk2(bf2f(gr.x & 0xffffu) * (acc[nt].x + bias), bf2f(gr.x >> 16) * (acc[nt].y + bias)); w.y = pk2(bf2f(gr.y & 0xffffu) * (acc[nt].z + bias), bf2f(gr.y >> 16) * (acc[nt].w + bias));
        *(u32x2*)(yo + d) = w; }
    __syncthreads();
}

__device__ __forceinline__ void scan_unit(LAS unsigned char* lds, const P& p, int bh, int sl) {
    const int tid = opaque_tid(), lane = tid & 63, wv = tid >> 6, r16 = lane & 15, g4 = lane >> 4;
    LAS bf16_t* ST = (LAS bf16_t*)lds;
    LAS bf16_t* VN = ST + 16 * 136;
    const int b = bh >> 3, hh = bh & 7, grp = wv >> 2, rt = wv & 3;
    const bf16_t* DW = (const bf16_t*)(p.ws + OFF_DW); const float* DU = (const float*)(p.ws + OFF_DU); const bf16_t* DQG = (const bf16_t*)(p.ws + OFF_DQG);
    const bf16_t* DKT = (const bf16_t*)(p.ws + OFF_DKT); const bf16_t* DA = (const bf16_t*)(p.ws + OFF_DA); const float* DEG = (const float*)(p.ws + OFF_DEG);
    float* O = (float*)(p.ws + OFF_F);
    for (int i = tid; i < 16 * 136 / 2; i += 512) ((LAS unsigned*)ST)[i] = 0u;
    f32x4 sacc = {0.f, 0.f, 0.f, 0.f};
    __syncthreads();
    const bf16_t* a1b = (grp == 0 ? DW : DQG) + ((size_t)(bh * 32) * 64 + 16 * rt + r16) * 128 + 8 * g4;
    const bf16_t* a3b = DKT + ((size_t)(bh * 32) * 128 + 16 * wv + r16) * 64 + 8 * g4;
    const bf16_t* a2b = DA + ((size_t)(bh * 32) * 64 + 16 * rt + r16) * 64 + 8 * g4;
    const float* upb = DU + ((size_t)(bh * 32) * 64 + 16 * rt + 4 * g4) * 128 + sl * 16 + r16;
    bf16x8 af[4], kf[2], aa[2]; f32x4 uu; float eg;
#define SCAN_LOAD(n_) do { const int n__ = (n_); \
        _Pragma("unroll") for (int kk = 0; kk < 4; ++kk) af[kk] = *(const bf16x8*)(a1b + (size_t)n__ * 64 * 128 + 32 * kk); \
        kf[0] = *(const bf16x8*)(a3b + (size_t)n__ * 128 * 64); kf[1] = *(const bf16x8*)(a3b + (size_t)n__ * 128 * 64 + 32); \
        aa[0] = *(const bf16x8*)(a2b + (size_t)n__ * 64 * 64); aa[1] = *(const bf16x8*)(a2b + (size_t)n__ * 64 * 64 + 32); \
        { const float* up = upb + (size_t)n__ * 64 * 128; uu = (f32x4){up[0], up[128], up[256], up[384]}; } \
        eg = DEG[bh * 32 + n__]; } while (0)
    SCAN_LOAD(0);
    for (int n = 0; n < 32; ++n) {
        bf16x8 caf[4] = {af[0], af[1], af[2], af[3]}, ckf[2] = {kf[0], kf[1]}, caa[2] = {aa[0], aa[1]}; const f32x4 cuu = uu; const float ceg = eg;
        if (n + 1 < 32) SCAN_LOAD(n + 1);
        f32x4 acc1 = {0.f, 0.f, 0.f, 0.f};
#pragma unroll
        for (int kk = 0; kk < 4; ++kk) { const bf16x8 bfr = *(const LAS bf16x8*)(ST + r16 * 136 + 32 * kk + 8 * g4); acc1 = MFMA16(caf[kk], bfr, acc1); }
        if (grp == 0) { const f32x4 vn = cuu - acc1; u32x2 w; w.x = pk2(vn.x, vn.y); w.y = pk2(vn.z, vn.w); *(LAS u32x2*)(VN + r16 * 72 + 16 * rt + 4 * g4) = w; }
        __syncthreads();
        const bf16x8 v0 = *(const LAS bf16x8*)(VN + r16 * 72 + 8 * g4), v1 = *(const LAS bf16x8*)(VN + r16 * 72 + 32 + 8 * g4);
        if (grp == 1) { acc1 = MFMA16(caa[0], v0, acc1); acc1 = MFMA16(caa[1], v1, acc1);
            float* op = O + ((size_t)(b * 2048 + n * 64 + 16 * rt + 4 * g4)) * 1024 + hh * 128 + sl * 16 + r16;
            op[0] = acc1.x; op[1024] = acc1.y; op[2048] = acc1.z; op[3072] = acc1.w; }
        sacc *= ceg;
        sacc = MFMA16(ckf[0], v0, sacc); sacc = MFMA16(ckf[1], v1, sacc);
        { u32x2 w; w.x = pk2(sacc.x, sacc.y); w.y = pk2(sacc.z, sacc.w); *(LAS u32x2*)(ST + r16 * 136 + 16 * wv + 4 * g4) = w; }
        __syncthreads();
    }
#undef SCAN_LOAD
}

__device__ __forceinline__ void attn_unit(LAS unsigned char* lds, const P& p, int l, int uid) {
    const int tid = opaque_tid(), lane = tid & 63, wv = tid >> 6, r16 = lane & 15, g4 = lane >> 4;
    const int b = uid >> 6, hh = (uid >> 4) & 3, qt = uid & 15; const int t0 = b * 2048 + qt * 128;
    const bf16_t* kbase = (const bf16_t*)(p.ws + OFF_KB) + (size_t)l * 1024 * 2048 + (size_t)(b * 256) * 2048 + hh * 512;
    const bf16_t* vbase = (const bf16_t*)(p.ws + OFF_VT) + (size_t)l * 1024 * 2048 + (size_t)((b * 4 + hh) * 512) * 256;
    const bf16_t* qrow = (const bf16_t*)(p.ws + OFF_Y) + (size_t)(t0 + 16 * wv + r16) * 2048 + hh * 512 + 8 * g4;
    bf16_t* orow = (bf16_t*)(p.ws + OFF_AO) + (size_t)(t0 + 16 * wv + r16) * 2048 + hh * 512 + 4 * g4;
    u32x4 pre[4];
#define ATT_LOADK(dc) do { _Pragma("unroll") for (int i = 0; i < 4; ++i) { const int pi = tid + 512 * i; pre[i] = *(const u32x4*)(kbase + (size_t)(pi >> 3) * 2048 + (dc) * 64 + (pi & 7) * 8); } } while (0)
#define ATT_WRITEK(buf) do { _Pragma("unroll") for (int i = 0; i < 4; ++i) { const int pi = tid + 512 * i; *(LAS u32x4*)((buf) + (pi >> 3) * 144 + (pi & 7) * 16) = pre[i]; } } while (0)
#define ATT_LOADV(dc) do { _Pragma("unroll") for (int i = 0; i < 4; ++i) { const int pi = tid + 512 * i; pre[i] = *(const u32x4*)(vbase + (size_t)((dc) * 64 + (pi >> 5)) * 256 + (pi & 31) * 8); } } while (0)
#define ATT_WRITEV(buf) do { _Pragma("unroll") for (int i = 0; i < 4; ++i) { const int pi = tid + 512 * i; *(LAS u32x4*)((buf) + (pi >> 5) * 528 + (pi & 31) * 16) = pre[i]; } } while (0)
    f32x4 sacc[16];
#pragma unroll
    for (int i = 0; i < 16; ++i) sacc[i] = (f32x4){0.f, 0.f, 0.f, 0.f};
    ATT_LOADK(0); ATT_WRITEK(lds); __syncthreads();
    for (int dc = 0; dc < 8; ++dc) {
        LAS unsigned char* cur = lds + (dc & 1) * 36864; LAS unsigned char* nxt = lds + ((dc + 1) & 1) * 36864;
        if (dc < 7) ATT_LOADK(dc + 1); else ATT_LOADV(0);
        const bf16x8 qf0 = *(const bf16x8*)(qrow + dc * 64), qf1 = *(const bf16x8*)(qrow + dc * 64 + 32);
#pragma unroll
        for (int n = 0; n < 16; ++n) { const LAS unsigned char* rp = cur + (16 * n + r16) * 144 + g4 * 16;
            const bf16x8 kf0 = *(const LAS bf16x8*)rp, kf1 = *(const LAS bf16x8*)(rp + 64);
            sacc[n] = MFMA16(kf0, qf0, sacc[n]); sacc[n] = MFMA16(kf1, qf1, sacc[n]); }
        if (dc < 7) ATT_WRITEK(nxt); else ATT_WRITEV(nxt);
        __syncthreads();
    }
    float mx = -3.0e38f;
#pragma unroll
    for (int n = 0; n < 16; ++n) mx = fmaxf(mx, fmaxf(fmaxf(sacc[n].x, sacc[n].y), fmaxf(sacc[n].z, sacc[n].w)));
    mx = fmaxf(mx, __shfl_xor(mx, 16)); mx = fmaxf(mx, __shfl_xor(mx, 32));
    float sum = 0.f;
#pragma unroll
    for (int n = 0; n < 16; ++n) {
#pragma unroll
        for (int r = 0; r < 4; ++r) { const float e = exp2f((sacc[n][r] - mx) * 1.4426950408889634f); sacc[n][r] = e; sum += e; } }
    sum += __shfl_xor(sum, 16); sum += __shfl_xor(sum, 32);
    const float inv = 1.0f / sum;
    bf16x8 pf[8];
#pragma unroll
    for (int kk = 0; kk < 8; ++kk) pf[kk] = mk8(pk2(sacc[2 * kk].x, sacc[2 * kk].y), pk2(sacc[2 * kk].z, sacc[2 * kk].w), pk2(sacc[2 * kk + 1].x, sacc[2 * kk + 1].y), pk2(sacc[2 * kk + 1].z, sacc[2 * kk + 1].w));
    for (int dc = 0; dc < 8; ++dc) {
        LAS unsigned char* cur = lds + (dc & 1) * 36864; LAS unsigned char* nxt = lds + ((dc + 1) & 1) * 36864;
        if (dc < 7) ATT_LOADV(dc + 1);
        f32x4 oacc[4];
#pragma unroll
        for (int nd = 0; nd < 4; ++nd) { oacc[nd] = (f32x4){0.f, 0.f, 0.f, 0.f}; const LAS unsigned char* rp = cur + (16 * nd + r16) * 528 + g4 * 8;
#pragma unroll
            for (int kk = 0; kk < 8; ++kk) { const u32x2 lo = *(const LAS u32x2*)(rp + kk * 64), hi = *(const LAS u32x2*)(rp + kk * 64 + 32);
                oacc[nd] = MFMA16(mk8(lo.x, lo.y, hi.x, hi.y), pf[kk], oacc[nd]); } }
#pragma unroll
        for (int nd = 0; nd < 4; ++nd) { u32x2 w; w.x = pk2(oacc[nd].x * inv, oacc[nd].y * inv); w.y = pk2(oacc[nd].z * inv, oacc[nd].w * inv); *(u32x2*)(orow + dc * 64 + 16 * nd) = w; }
        if (dc < 7) ATT_WRITEV(nxt);
        __syncthreads();
    }
#undef ATT_LOADK
#undef ATT_WRITEK
#undef ATT_LOADV
#undef ATT_WRITEV
}

#if defined(DBG_STOP)
__device__ __forceinline__ float dbg_get(const void* p, int isf32, size_t idx) { return isf32 ? ((const float*)p)[idx] : bf2f(((const bf16_t*)p)[idx]); }
__device__ __forceinline__ void dbg_dump(float* out, const void* a, int af32, size_t lda, size_t a0, const void* b, int bf32, size_t ldb, size_t b0) {
    for (size_t i = (size_t)blockIdx.x * 512 + threadIdx.x; i < (size_t)T_ * 2048; i += (size_t)gridDim.x * 512) { const size_t t = i >> 11, c = i & 2047;
        out[i] = c < 1024 ? dbg_get(a, af32, t * lda + a0 + c) : dbg_get(b, bf32, t * ldb + b0 + (c - 1024)); } }
#endif
__global__ void __launch_bounds__(512, 2) mk_fwd(P p) {
    extern __shared__ __attribute__((aligned(16))) unsigned char lds_raw[];
    LAS unsigned char* lds = (LAS unsigned char*)lds_raw;
    cg::grid_group grid = cg::this_grid();
#define GSYNC() do { asm volatile("s_waitcnt vmcnt(0) lgkmcnt(0)" ::: "memory"); __builtin_amdgcn_fence(__ATOMIC_RELEASE, "agent"); grid.sync(); __builtin_amdgcn_fence(__ATOMIC_ACQUIRE, "agent"); } while (0)
    const int G = gridDim.x, bx = blockIdx.x;
    unsigned char* ws = p.ws;
    bf16_t* H = (bf16_t*)(ws + OFF_H); bf16_t* BIG = (bf16_t*)(ws + OFF_BIG); float* F = (float*)(ws + OFF_F); bf16_t* Y = (bf16_t*)(ws + OFF_Y); bf16_t* AO = (bf16_t*)(ws + OFF_AO);

    phase0(lds, p);
    GSYNC();
#pragma unroll 1
    for (int l = 0; l < 2; ++l) {
#pragma unroll 1
        for (int ffn = 0; ffn < 2; ++ffn) {
            if (ffn == 1) {
                {
                    pg8::Gemm g{H, (const bf16_t*)(ws + OFF_WIN + (size_t)l * SZ_WIN), T_, 6144, 2048}; pg8::StaticOrder S; S.init(T_, 6144, G, bx);
                    pg8::EpiIn E{BIG, (float*)(ws + OFF_STATS) + (size_t)l * T_ * 32};
                    pg8::gemm_phase<pg8::EpiIn, pg8::StaticOrder>(lds, g, S, E, nullptr);
                    const float* alog = p.in[9] + l * 8; const float* dtb = p.in[10] + l * 8; float* BG = (float*)(ws + OFF_BG);
                    const int tid = opaque_tid(), lane = tid & 63, wv = tid >> 6, r16 = lane & 15, g4 = lane >> 4;
                    for (int rp = bx; rp < 256; rp += G) {
                        const int rt = 2 * rp + (wv >> 2), kq = wv & 3;
                        const bf16_t* ap = H + (size_t)(16 * rt + r16) * 2048 + 512 * kq + 8 * g4;
                        const bf16_t* bp = (const bf16_t*)(ws + OFF_WBA) + (size_t)l * 16 * 2048 + (size_t)r16 * 2048 + 512 * kq + 8 * g4;
                        f32x4 acc = {0.f, 0.f, 0.f, 0.f};
#pragma unroll 4
                        for (int kk = 0; kk < 16; ++kk) acc = MFMA16(*(const bf16x8*)(ap + 32 * kk), *(const bf16x8*)(bp + 32 * kk), acc);
                        LAS f32x4* red = (LAS f32x4*)lds; red[wv * 64 + lane] = acc; __syncthreads();
                        if (kq == 0) { const f32x4 s = red[wv * 64 + lane] + red[(wv + 1) * 64 + lane] + red[(wv + 2) * 64 + lane] + red[(wv + 3) * 64 + lane];
#pragma unroll
                            for (int r = 0; r < 4; ++r) { const float v = s[r]; float o;
                                if (r16 < 8) o = 1.0f / (1.0f + __expf(-v));
                                else { const float a = v + dtb[r16 - 8]; const float sp = a > 20.f ? a : log1pf(__expf(a)); o = -__expf(alog[r16 - 8]) * sp; }
                                BG[(size_t)(16 * rt + 4 * g4 + r) * 16 + r16] = o; } }
                        __syncthreads();
                    }
                }
                GSYNC();
#if defined(DBG_STOP)
                if (l == 0 && DBG_STOP == 5) { dbg_dump(p.out, BIG, 0, 6144, 0, BIG, 0, 6144, 1024); return; }
                if (l == 0 && DBG_STOP == 6) { dbg_dump(p.out, BIG, 0, 6144, 2048, BIG, 0, 6144, 3072); return; }
                if (l == 0 && DBG_STOP == 7) { dbg_dump(p.out, BIG, 0, 6144, 4096, BIG, 0, 6144, 5120); return; }
                if (l == 0 && DBG_STOP == 12) { dbg_dump(p.out, ws + OFF_BG, 1, 16, 0, ws + OFF_STATS, 1, 32, 0); return; }
#endif
                for (int u = bx; u < 1536; u += G) { if (u < 1024) wy_unit(lds, p, l, u); else sgu_unit(lds, p, l, u - 1024); }
                GSYNC();
#if defined(DBG_STOP)
                if (l == 0 && DBG_STOP == 8) { dbg_dump(p.out, Y, 0, 2048, 0, ws + OFF_DU, 1, 1024, 0); return; }
                if (l == 0 && DBG_STOP == 9) { dbg_dump(p.out, ws + OFF_DW, 0, 1024, 0, ws + OFF_DQG, 0, 1024, 0); return; }
                if (l == 0 && DBG_STOP == 10) { dbg_dump(p.out, ws + OFF_DKT, 0, 1024, 0, ws + OFF_DKT, 0, 1024, 0); return; }
                if (l == 0 && DBG_STOP == 14) { dbg_dump(p.out, ws + OFF_DA, 0, 256, (size_t)T_ * 256, ws + OFF_DEG, 1, 0, 0); return; }
                if (l == 0 && DBG_STOP == 13) { dbg_dump(p.out, ws + OFF_DA, 0, 256, 0, ws + OFF_DA, 0, 256, 0); return; }
#endif
                for (int u = bx; u < 256; u += G) scan_unit(lds, p, (u & 7) + 8 * (u >> 6), (u >> 3) & 7);
                GSYNC();
#if defined(DBG_STOP)
                if (l == 0 && DBG_STOP == 11) { dbg_dump(p.out, F, 1, 1024, 0, F, 1, 1024, 0); return; }
#endif
                {
                    const int tid = opaque_tid(), lane = tid & 63, wv = tid >> 6;
                    const float* O = F; const float* dnw = p.in[15] + l * 128; const float w0 = dnw[lane * 2], w1 = dnw[lane * 2 + 1];
                    for (int t = bx * 8 + wv; t < T_; t += G * 8) {
#pragma unroll
                        for (int hh = 0; hh < 8; ++hh) { const f32x2 ov = *(const f32x2*)(O + (size_t)t * 1024 + hh * 128 + lane * 2);
                            const float rs = rsqrtf(wave_sum(ov.x * ov.x + ov.y * ov.y) * (1.0f / 128.0f) + EPS);
                            const unsigned zr = *(const unsigned*)(BIG + (size_t)t * 6144 + 5120 + hh * 128 + lane * 2);
                            *(unsigned*)(Y + (size_t)t * 2048 + 1024 + hh * 128 + lane * 2) = pk2(ov.x * rs * w0 * pg8::silu_f(bf2f(zr & 0xffffu)), ov.y * rs * w1 * pg8::silu_f(bf2f(zr >> 16))); }
                    }
                }
                GSYNC();
                { pg8::Gemm g{Y, (const bf16_t*)(ws + OFF_WOUT + (size_t)l * SZ_WSQ), T_, 2048, 2048}; pg8::StaticOrder S; S.init(T_, 2048, G, bx); pg8::EpiF32 E{F, 2048, nullptr};
                  pg8::gemm_phase<pg8::EpiF32, pg8::StaticOrder>(lds, g, S, E, nullptr); }
                GSYNC();
                rowpass(T_, F, p.in[17] + l * 2048, 1.0f, p.out, p.out, p.in[18] + l * 2048, H);
#if defined(DBG_STOP)
                if (DBG_STOP == 2 && l == 0) return;
#endif
                GSYNC();
                { pg8::Gemm g{H, (const bf16_t*)(ws + OFF_WXQ + (size_t)l * SZ_WSQ), T_, 2048, 2048}; pg8::StaticOrder S; S.init(T_, 2048, G, bx); pg8::EpiScaleBf16 E{Y, 2048, 0.04419417382415922f};
                  pg8::gemm_phase<pg8::EpiScaleBf16, pg8::StaticOrder>(lds, g, S, E, nullptr); }
                GSYNC();
                for (int u = bx; u < 256; u += G) attn_unit(lds, p, l, u);
                GSYNC();
                { pg8::Gemm g{AO, (const bf16_t*)(ws + OFF_WXO + (size_t)l * SZ_WSQ), T_, 2048, 2048}; pg8::StaticOrder S; S.init(T_, 2048, G, bx); pg8::EpiF32 E{F, 2048, nullptr};
                  pg8::gemm_phase<pg8::EpiF32, pg8::StaticOrder>(lds, g, S, E, nullptr); }
                GSYNC();
                rowpass(T_, F, p.in[23] + l * 2048, 1.0f, p.out, p.out, p.in[24] + l * 2048, H);
#if defined(DBG_STOP)
                if (DBG_STOP == 3 && l == 0) return;
#endif
                GSYNC();
            }
            { pg8::Gemm g{H, (const bf16_t*)(ws + OFF_WGU + (size_t)(ffn * 2 + l) * SZ_WGU), T_, 11264, 2048}; pg8::StaticOrder S; S.init(T_, 11264, G, bx); pg8::EpiSwiglu E{BIG};
              pg8::gemm_phase<pg8::EpiSwiglu, pg8::StaticOrder>(lds, g, S, E, nullptr);
              if (l == 0 && ffn == 0) {
#pragma unroll 1
                  for (int ll = 0; ll < 2; ++ll) {
                      pg8::Gemm g2{(const bf16_t*)(ws + OFF_MEMH) + (size_t)ll * 1024 * 2048, (const bf16_t*)(ws + OFF_WKV + (size_t)ll * SZ_WKV), 1024, 4096, 2048};
                      pg8::TailOrder S2{G, bx, 64 * ll, 64, 16};
                      pg8::EpiKV E2{(bf16_t*)(ws + OFF_KB) + (size_t)ll * 1024 * 2048, (bf16_t*)(ws + OFF_VT) + (size_t)ll * 1024 * 2048};
                      pg8::gemm_phase<pg8::EpiKV, pg8::TailOrder>(lds, g2, S2, E2, nullptr); } } }
            GSYNC();
            { pg8::Gemm g{BIG, (const bf16_t*)(ws + OFF_WD + (size_t)(ffn * 2 + l) * SZ_WD), T_, 2048, 5632}; pg8::StaticOrder S; S.init(T_, 2048, G, bx); pg8::EpiF32 E{F, 2048, nullptr};
              pg8::gemm_phase<pg8::EpiF32, pg8::StaticOrder>(lds, g, S, E, nullptr); }
            GSYNC();
            {   const float* gpost = (ffn == 0 ? p.in[5] : p.in[27]) + l * 2048;
                const float* gpre = ffn == 0 ? p.in[6] + l * 2048 : (l == 0 ? p.in[2] + 2048 : nullptr);
                rowpass(T_, F, gpost, 0.5f, p.out, p.out, gpre, gpre ? H : nullptr); }
#if defined(DBG_STOP)
            if (DBG_STOP == 1 && l == 0 && ffn == 0) return;
            if (DBG_STOP == 4 && l == 0 && ffn == 1) return;
#endif
            if (!(l == 1 && ffn == 1)) GSYNC();
        }
    }
}

extern "C" void kernel_launch(void* const* d_in, const int* in_sizes, int n_in, void* d_out, int out_size, void* d_ws, size_t ws_size, hipStream_t stream) {
    static int grid = 0;
    if (grid == 0) {
        int dev = 0, cus = 0, per_cu = 0;
        if (hipGetDevice(&dev) != hipSuccess || hipDeviceGetAttribute(&cus, hipDeviceAttributeMultiprocessorCount, dev) != hipSuccess) { fprintf(stderr, "kernel_launch: device query failed\n"); grid = -1; return; }
        if (hipFuncSetAttribute((const void*)mk_fwd, hipFuncAttributeMaxDynamicSharedMemorySize, LDS_BYTES) != hipSuccess) { fprintf(stderr, "kernel_launch: hipFuncSetAttribute failed\n"); grid = -1; return; }
        if (hipOccupancyMaxActiveBlocksPerMultiprocessor(&per_cu, (const void*)mk_fwd, 512, LDS_BYTES) != hipSuccess || per_cu < 1) fprintf(stderr, "kernel_launch: occupancy query says %d blocks per CU\n", per_cu);
        (void)hipGetLastError();
        if (n_in != 28 || ws_size < WS_END || cus != 256) { fprintf(stderr, "kernel_launch: unexpected setup n_in %d ws %zu (need %zu) cus %d\n", n_in, ws_size, (size_t)WS_END, cus); }
        grid = 256;
    }
    if (grid < 0) return;
    P a{};
    for (int i = 0; i < 28; ++i) a.in[i] = (const float*)d_in[i];
    a.out = (float*)d_out; a.ws = (unsigned char*)d_ws;
    void* args[] = {&a};
    const hipError_t e = hipLaunchCooperativeKernel((const void*)mk_fwd, dim3(grid), dim3(512), args, LDS_BYTES, stream);
    if (e != hipSuccess) fprintf(stderr, "kernel_launch: cooperative launch failed: %s\n", hipGetErrorString(e));
}
```

```cpp
#include <hip/hip_runtime.h>
#include <hip/hip_cooperative_groups.h>
#include <cstdio>
namespace cg = cooperative_groups;
__device__ __forceinline__ int opaque_tid() { int t = threadIdx.x; asm volatile("" : "+v"(t)); return t; }
namespace pg8 {
#define PG8_LAS __attribute__((address_space(3)))
typedef unsigned short bf16_t;
typedef short bf16x8 __attribute__((ext_vector_type(8)));
typedef float f32x4 __attribute__((ext_vector_type(4)));
typedef unsigned u32x4 __attribute__((ext_vector_type(4)));
constexpr int BM = 256, BK = 64, HALF = 128, HTB = HALF * BK * 2  , STAGE_BYTES = 8 * HTB, NXCD = 8, WGM = 8;

__host__ __device__ __forceinline__ int lds_byte(int r, int c) { const int st = (r >> 4) * 2 + (c >> 5), rr = r & 15, cc = c & 31, ob = rr * 64 + cc * 2; return st * 1024 + (ob ^ (((ob >> 9) & 1) << 5)); }
__host__ __device__ __forceinline__ void stage_rc(int b, int& R, int& C) { const int st = b / 1024, sb = b % 1024, swz = sb ^ (((sb >> 9) & 1) << 5); R = (st >> 1) * 16 + swz / 64; C = (st & 1) * 32 + (swz % 64) / 2; }
__host__ __device__ __forceinline__ int perm32(int rho) { const int n = rho >> 4, i = rho & 15; return 8 * (i >> 2) + 4 * n + (i & 3); }

struct Unit { int pm, pn; };
struct Gemm { const bf16_t* A; const bf16_t* Bt; int M, N, K; };

struct StaticOrder {
    int nM, nN, nwg, G, c;
    __host__ __device__ void init(int M, int N, int G_, int c_) { nM = M / BM; nN = N / BM; nwg = nM * nN; G = G_; c = c_; }
    __host__ __device__ bool next(int i, Unit& u) const {
        const long L = (long)i * G + c; if (L >= nwg) return false;
        int wgid = (int)L; { const int q = nwg / NXCD, r = nwg % NXCD, xcd = wgid % NXCD, off = wgid / NXCD; wgid = (xcd < r ? xcd * (q + 1) : r * (q + 1) + (xcd - r) * q) + off; }
        const int nig = WGM * nN, gid = wgid / nig, fm = gid * WGM, gsz = (nM - fm) < WGM ? (nM - fm) : WGM;
        u.pm = fm + ((wgid % nig) % gsz); u.pn = (wgid % nig) / gsz; return true;
    }
    __device__ __forceinline__ void a_ready(const Unit&) const {}
    __device__ __forceinline__ void done(const Unit&) const {}
};
typedef __bf16 bf16v2_t __attribute__((ext_vector_type(2)));
typedef float f32x2_cv __attribute__((ext_vector_type(2)));
__device__ __forceinline__ unsigned cvt_pk_bf16(float lo, float hi) { const f32x2_cv v = {lo, hi}; return __builtin_bit_cast(unsigned, __builtin_convertvector(v, bf16v2_t)); }
typedef float f32x2 __attribute__((ext_vector_type(2)));
__device__ __forceinline__ f32x2 gelu_pk(f32x2 v) {
    const f32x2 av = __builtin_elementwise_abs(v), d = av * 0.2316418882f + 1.0f;
    f32x2 t; t.x = __builtin_amdgcn_rcpf(d.x); t.y = __builtin_amdgcn_rcpf(d.y);
    f32x2 q = t * 0.5307027145f + (-0.7265760135f); q = q * t + 0.7107068705f; q = q * t + (-0.142248368f); q = q * t + 0.127414796f; q = q * t;
    const f32x2 s = (v * v) * (-0.72134752044f);
    f32x2 e; e.x = __builtin_amdgcn_exp2f(s.x); e.y = __builtin_amdgcn_exp2f(s.y);
    const f32x2 m = v * (q * e), r = v - m;
    f32x2 o; o.x = v.x < 0.f ? m.x : r.x; o.y = v.y < 0.f ? m.y : r.y; return o;
}

struct EpiF32 {
    static constexpr bool PERM = false, AFTER_DRAIN = false;
    float* C; int ldc; const float* bias;
    __device__ __forceinline__ void operator()(const f32x4 (&acc)[2][2][4][2], const Unit& u, int wr, int wc, int fr, int fq) const {
        const int row0 = u.pm * BM + wr * 64 + fr, col0 = u.pn * BM + wc * 32 + 4 * fq;
        f32x4 bv[2][2];
#pragma unroll
        for (int bj = 0; bj < 2; ++bj)
#pragma unroll
            for (int n = 0; n < 2; ++n) bv[bj][n] = bias ? *(const f32x4*)(bias + col0 + bj * HALF + n * 16) : (f32x4){0.f, 0.f, 0.f, 0.f};
#pragma unroll
        for (int ai = 0; ai < 2; ++ai)
#pragma unroll
            for (int m = 0; m < 4; ++m) { float* rowp = C + (size_t)(row0 + ai * HALF + m * 16) * ldc + col0;
#pragma unroll
                for (int bj = 0; bj < 2; ++bj)
#pragma unroll
                    for (int n = 0; n < 2; ++n) *(f32x4*)(rowp + bj * HALF + n * 16) = acc[ai][bj][m][n] + bv[bj][n]; }
    }
};
typedef unsigned u32x2 __attribute__((ext_vector_type(2)));
__device__ __forceinline__ float silu_f(float g) { return g * __builtin_amdgcn_rcpf(1.0f + __expf(-g)); }
struct EpiSwiglu {
    static constexpr bool PERM = true, AFTER_DRAIN = false;
    bf16_t* O;
    __device__ __forceinline__ void operator()(const f32x4 (&acc)[2][2][4][2], const Unit& u, int wr, int wc, int fr, int fq) const {
        const int row0 = u.pm * BM + wr * 64 + fr, col0 = u.pn * HALF + wc * 32 + 8 * fq;
#pragma unroll
        for (int ai = 0; ai < 2; ++ai)
#pragma unroll
            for (int m = 0; m < 4; ++m) { bf16_t* rowp = O + (size_t)(row0 + ai * HALF + m * 16) * 5632 + col0;
                const f32x4 g0 = acc[ai][0][m][0], g1 = acc[ai][0][m][1], u0 = acc[ai][1][m][0], u1 = acc[ai][1][m][1];
                f32x4 v0, v1;
#pragma unroll
                for (int j = 0; j < 4; ++j) { v0[j] = silu_f(g0[j]) * u0[j]; v1[j] = silu_f(g1[j]) * u1[j]; }
                u32x4 w; w.x = cvt_pk_bf16(v0[0], v0[1]); w.y = cvt_pk_bf16(v0[2], v0[3]); w.z = cvt_pk_bf16(v1[0], v1[1]); w.w = cvt_pk_bf16(v1[2], v1[3]);
                *(u32x4*)rowp = w; }
    }
};
struct EpiIn {
    static constexpr bool PERM = true, AFTER_DRAIN = false;
    bf16_t* O; float* stats;
    __device__ __forceinline__ void operator()(const f32x4 (&acc)[2][2][4][2], const Unit& u, int wr, int wc, int fr, int fq) const {
        const int row0 = u.pm * BM + wr * 64 + fr, col0 = u.pn * BM + wc * 32 + 8 * fq;
        const int mode = u.pn < 4 ? 1 : (u.pn < 8 ? 2 : 0);
#pragma unroll
        for (int ai = 0; ai < 2; ++ai)
#pragma unroll
            for (int m = 0; m < 4; ++m) { const int row = row0 + ai * HALF + m * 16; bf16_t* rowp = O + (size_t)row * 6144 + col0; float s = 0.f, q = 0.f;
#pragma unroll
                for (int bj = 0; bj < 2; ++bj) { f32x4 v0 = acc[ai][bj][m][0], v1 = acc[ai][bj][m][1];
                    if (mode) { f32x2 a = gelu_pk((f32x2){v0[0], v0[1]}), b = gelu_pk((f32x2){v0[2], v0[3]}), c = gelu_pk((f32x2){v1[0], v1[1]}), d = gelu_pk((f32x2){v1[2], v1[3]});
                        v0 = (f32x4){a.x, a.y, b.x, b.y}; v1 = (f32x4){c.x, c.y, d.x, d.y}; }
                    if (mode == 2) {
#pragma unroll
                        for (int j = 0; j < 4; ++j) { s += v0[j] + v1[j]; q += v0[j] * v0[j] + v1[j] * v1[j]; } }
                    u32x4 w; w.x = cvt_pk_bf16(v0[0], v0[1]); w.y = cvt_pk_bf16(v0[2], v0[3]); w.z = cvt_pk_bf16(v1[0], v1[1]); w.w = cvt_pk_bf16(v1[2], v1[3]);
                    *(u32x4*)(rowp + bj * HALF) = w; }
                if (mode == 2) { s += __shfl_xor(s, 16); s += __shfl_xor(s, 32); q += __shfl_xor(q, 16); q += __shfl_xor(q, 32);
                    if (fq == 0) *(f32x2*)(stats + ((size_t)row * 16 + (u.pn - 4) * 4 + wc) * 2) = (f32x2){s, q}; } }
    }
};
struct EpiScaleBf16 {
    static constexpr bool PERM = true, AFTER_DRAIN = false;
    bf16_t* O; int ldc; float scale;
    __device__ __forceinline__ void operator()(const f32x4 (&acc)[2][2][4][2], const Unit& u, int wr, int wc, int fr, int fq) const {
        const int row0 = u.pm * BM + wr * 64 + fr, col0 = u.pn * BM + wc * 32 + 8 * fq;
#pragma unroll
        for (int ai = 0; ai < 2; ++ai)
#pragma unroll
            for (int m = 0; m < 4; ++m) { bf16_t* rowp = O + (size_t)(row0 + ai * HALF + m * 16) * ldc + col0;
#pragma unroll
                for (int bj = 0; bj < 2; ++bj) { const f32x4 v0 = acc[ai][bj][m][0] * scale, v1 = acc[ai][bj][m][1] * scale;
                    u32x4 w; w.x = cvt_pk_bf16(v0[0], v0[1]); w.y = cvt_pk_bf16(v0[2], v0[3]); w.z = cvt_pk_bf16(v1[0], v1[1]); w.w = cvt_pk_bf16(v1[2], v1[3]);
                    *(u32x4*)(rowp + bj * HALF) = w; } }
    }
};
struct EpiKV {
    static constexpr bool PERM = true, AFTER_DRAIN = false;
    bf16_t* Kb; bf16_t* Vt;
    __device__ __forceinline__ void operator()(const f32x4 (&acc)[2][2][4][2], const Unit& u, int wr, int wc, int fr, int fq) const {
        const int row0 = u.pm * BM + wr * 64 + fr, col0 = u.pn * BM + wc * 32 + 8 * fq;
#pragma unroll
        for (int ai = 0; ai < 2; ++ai)
#pragma unroll
            for (int m = 0; m < 4; ++m) { const int row = row0 + ai * HALF + m * 16;
#pragma unroll
                for (int bj = 0; bj < 2; ++bj) { const f32x4 v0 = acc[ai][bj][m][0], v1 = acc[ai][bj][m][1]; const int col = col0 + bj * HALF;
                    if (u.pn < 8) { u32x4 w; w.x = cvt_pk_bf16(v0[0], v0[1]); w.y = cvt_pk_bf16(v0[2], v0[3]); w.z = cvt_pk_bf16(v1[0], v1[1]); w.w = cvt_pk_bf16(v1[2], v1[3]);
                        *(u32x4*)(Kb + (size_t)row * 2048 + col) = w; }
                    else { const int cc = col - 2048, hh = cc >> 9, d = cc & 511, bb = row >> 8, mm = row & 255;
                        bf16_t* vp = Vt + ((size_t)((bb * 4 + hh) * 512 + d)) * 256 + mm;
#pragma unroll
                        for (int j = 0; j < 4; ++j) { vp[(size_t)j * 256] = (bf16_t)(cvt_pk_bf16(v0[j], 0.f) & 0xffffu); vp[(size_t)(4 + j) * 256] = (bf16_t)(cvt_pk_bf16(v1[j], 0.f) & 0xffffu); } } } }
    }
};
struct TailOrder {
    int G, c, off, n, nN;
    __device__ bool next(int i, Unit& u) const { if (i > 0) return false; const int idx = (G - 1 - c) - off; if (idx < 0 || idx >= n) return false; u.pm = idx / nN; u.pn = idx % nN; return true; }
    __device__ __forceinline__ void a_ready(const Unit&) const {}
    __device__ __forceinline__ void done(const Unit&) const {}
};
template <class Epi, class Sched, bool STAMP = false>
__device__ __forceinline__ void gemm_phase(PG8_LAS unsigned char* lds, const Gemm g, const Sched& S, const Epi& E, unsigned long long* stamps) {
    const int tid = opaque_tid(), wid = __builtin_amdgcn_readfirstlane(tid >> 6), lane = tid & 63, wr = wid >> 2, wc = wid & 3, fr = lane & 15, fq = lane >> 4;
    const int K = g.K, nt = K / BK;
    int ts_lo = 0, ts_hi = 0, nts = 0; const unsigned long long rt_entry = STAMP ? (unsigned long long)wall_clock64() : 0ull;
#define PG8_STAMP() do { if (STAMP && wid == 0 && nts < 64) { const unsigned long long _c = (unsigned long long)clock64(); \
        ts_lo = (lane == nts) ? (int)(unsigned)_c : ts_lo; ts_hi = (lane == nts) ? (int)(unsigned)(_c >> 32) : ts_hi; ++nts; } } while (0)
    PG8_STAMP();
    unsigned voffA[2], voffB[2];
#pragma unroll
    for (int i = 0; i < 2; ++i) { int R, C; stage_rc(tid * 16 + i * 8192, R, C); const int Rb = Epi::PERM ? ((R & ~31) + perm32(R & 31)) : R;
        voffA[i] = (unsigned)(R * K + C) * 2u; voffB[i] = (unsigned)(Rb * K + C) * 2u; }
    const size_t kstep = (size_t)(BK * 2);
    const size_t hstep = (size_t)HALF * K * 2;
    const size_t tstep = 2 * hstep;
    const unsigned ldsw = (unsigned)wid * 1024u;
    const int aoff = lds_byte(wr * 64 + fr, fq * 8), boff = lds_byte(wc * 32 + fr, fq * 8);
#define PG8_SA(b, h) (((b) * 2 + (h)) * HTB)
#define PG8_SB(b, h) ((4 + (b) * 2 + (h)) * HTB)
#define PG8_STAGE(bufoff, gbase, voff) do { _Pragma("unroll") for (int _i = 0; _i < 2; ++_i) \
        __builtin_amdgcn_global_load_lds((const unsigned*)((const char*)(gbase) + (voff)[_i]), (PG8_LAS unsigned*)(lds + (bufoff) + ldsw + _i * 8192), 16, 0, 0); } while (0)
#define PG8_LDA(dst, b, h) do { _Pragma("unroll") for (int m = 0; m < 4; ++m) _Pragma("unroll") for (int k = 0; k < 2; ++k) dst[m][k] = *(const PG8_LAS bf16x8*)(lds + PG8_SA(b, h) + aoff + m * 2048 + k * 1024); } while (0)
#define PG8_LDB(dst, b, h) do { _Pragma("unroll") for (int n = 0; n < 2; ++n) _Pragma("unroll") for (int k = 0; k < 2; ++k) dst[n][k] = *(const PG8_LAS bf16x8*)(lds + PG8_SB(b, h) + boff + n * 2048 + k * 1024); } while (0)
#define PG8_MMA(ai, bj, At, Bt) do { __builtin_amdgcn_s_setprio(1); _Pragma("unroll") for (int m = 0; m < 4; ++m) _Pragma("unroll") for (int n = 0; n < 2; ++n) _Pragma("unroll") for (int k = 0; k < 2; ++k) \
        acc[ai][bj][m][n] = __builtin_amdgcn_mfma_f32_16x16x32_bf16(Bt[n][k], At[m][k], acc[ai][bj][m][n], 0, 0, 0); __builtin_amdgcn_s_setprio(0); } while (0)
#define PG8_WAIT_V(n) asm volatile("s_waitcnt vmcnt(" #n ")" ::: "memory")
#define PG8_WAIT_L(n) asm volatile("s_waitcnt lgkmcnt(" #n ")" ::: "memory")
#define PG8_BAR __builtin_amdgcn_s_barrier()
#define PG8_SCHED __builtin_amdgcn_sched_barrier(0)
    Unit cur, nxt; int ui = 0;
    if (!S.next(0, cur)) return;
    f32x4 acc[2][2][4][2];
#pragma unroll
    for (int a = 0; a < 2; ++a)
#pragma unroll
        for (int b = 0; b < 2; ++b)
#pragma unroll
            for (int m = 0; m < 4; ++m)
#pragma unroll
                for (int n = 0; n < 2; ++n) acc[a][b][m][n] = (f32x4){0.f, 0.f, 0.f, 0.f};
    bf16x8 At[4][2], B0[2][2], B1[2][2];
    const char* cA = (const char*)g.A + (size_t)cur.pm * tstep; const char* cB = (const char*)g.Bt + (size_t)cur.pn * tstep;
    S.a_ready(cur);
    PG8_STAGE(PG8_SB(0, 0), cB, voffB); PG8_STAGE(PG8_SA(0, 0), cA, voffA); PG8_STAGE(PG8_SB(0, 1), cB + hstep, voffB); PG8_STAGE(PG8_SA(0, 1), cA + hstep, voffA);
    if (wr == 1) PG8_BAR;
    PG8_WAIT_V(4); PG8_BAR;
    PG8_STAGE(PG8_SB(1, 0), cB + kstep, voffB); PG8_STAGE(PG8_SA(1, 0), cA + kstep, voffA); PG8_STAGE(PG8_SB(1, 1), cB + hstep + kstep, voffB);
    PG8_WAIT_V(6); PG8_BAR;
    PG8_STAMP();
    for (;;) {
        const bool has_next = S.next(ui + 1, nxt);
        const char* nA = has_next ? (const char*)g.A + (size_t)nxt.pm * tstep : cA; const char* nB = has_next ? (const char*)g.Bt + (size_t)nxt.pn * tstep : cB;
        for (int t = 0; t < nt; t += 2) {
            const bool last = (t == nt - 2);
            const char* a1 = cA + (size_t)(t + 1) * kstep;
            const char* a2 = last ? nA : cA + (size_t)(t + 2) * kstep; const char* b2 = last ? nB : cB + (size_t)(t + 2) * kstep;
            const char* a3 = a2 + kstep; const char* b3 = b2 + kstep;
            if (last && has_next) S.a_ready(nxt);
            PG8_LDB(B0, 0, 0); PG8_SCHED; PG8_LDA(At, 0, 0); PG8_STAGE(PG8_SA(1, 1), a1 + hstep, voffA);
            PG8_WAIT_L(8); PG8_BAR; PG8_WAIT_L(0); PG8_MMA(0, 0, At, B0); PG8_BAR; PG8_SCHED;
            PG8_LDB(B1, 0, 1); PG8_STAGE(PG8_SB(0, 0), b2, voffB);
            PG8_BAR; PG8_WAIT_L(0); PG8_MMA(0, 1, At, B1); PG8_BAR;
            PG8_LDA(At, 0, 1); PG8_STAGE(PG8_SA(0, 0), a2, voffA);
            PG8_BAR; PG8_WAIT_L(0); PG8_MMA(1, 0, At, B0); PG8_BAR; PG8_SCHED;
            PG8_STAGE(PG8_SB(0, 1), b2 + hstep, voffB);
            PG8_WAIT_V(6); PG8_BAR; PG8_MMA(1, 1, At, B1); PG8_BAR;
            PG8_LDB(B0, 1, 0); PG8_SCHED; PG8_LDA(At, 1, 0); PG8_STAGE(PG8_SA(0, 1), a2 + hstep, voffA);
            PG8_WAIT_L(8); PG8_BAR; PG8_WAIT_L(0); PG8_MMA(0, 0, At, B0); PG8_BAR; PG8_SCHED;
            PG8_LDB(B1, 1, 1); PG8_STAGE(PG8_SB(1, 0), b3, voffB);
            PG8_BAR; PG8_WAIT_L(0); PG8_MMA(0, 1, At, B1); PG8_BAR;
            PG8_LDA(At, 1, 1); PG8_STAGE(PG8_SA(1, 0), a3, voffA);
            PG8_BAR; PG8_WAIT_L(0); PG8_MMA(1, 0, At, B0); PG8_BAR; PG8_SCHED;
            PG8_STAGE(PG8_SB(1, 1), b3 + hstep, voffB);
            PG8_WAIT_V(6); PG8_BAR; PG8_MMA(1, 1, At, B1); PG8_BAR;
        }
        PG8_STAMP();
        if constexpr (!Epi::AFTER_DRAIN) { E(acc, cur, wr, wc, fr, fq); S.done(cur); }
        PG8_STAMP();
        if (!has_next) break;
#pragma unroll
        for (int a = 0; a < 2; ++a)
#pragma unroll
            for (int b = 0; b < 2; ++b)
#pragma unroll
                for (int m = 0; m < 4; ++m)
#pragma unroll
                    for (int n = 0; n < 2; ++n) acc[a][b][m][n] = (f32x4){0.f, 0.f, 0.f, 0.f};
        cur = nxt; cA = nA; cB = nB; ++ui;
    }
    PG8_WAIT_V(0);
    if (wr == 0) PG8_BAR;
    PG8_BAR;
    if constexpr (Epi::AFTER_DRAIN) { E.fused(acc, cur, wr, wc, fr, fq, lds, wid, lane); S.done(cur); }
    PG8_STAMP();
    if (STAMP && wid == 0) { stamps[lane] = lane < nts ? (((unsigned long long)(unsigned)ts_hi << 32) | (unsigned)ts_lo) : 0ull;
        if (lane == 62) stamps[62] = rt_entry; if (lane == 63) stamps[63] = (unsigned long long)wall_clock64(); }
#undef PG8_STAMP
#undef PG8_SA
#undef PG8_SB
#undef PG8_STAGE
#undef PG8_LDA
#undef PG8_LDB
#undef PG8_MMA
#undef PG8_WAIT_V
#undef PG8_WAIT_L
#undef PG8_BAR
#undef PG8_SCHED
}
}
using pg8::silu_f; using pg8::bf16_t; using pg8::bf16x8; using pg8::f32x4; using pg8::f32x2; using pg8::u32x4; using pg8::u32x2; using pg8::cvt_pk_bf16;
#define LAS __attribute__((address_space(3)))
#ifndef REP_CONV
#define REP_CONV 1
#endif
#ifndef REP_GEMM
#define REP_GEMM 1
#endif
#ifndef REP_ROW
#define REP_ROW 0
#endif
#ifndef REP_WY
#define REP_WY 1
#endif
#ifndef REP_SCAN
#define REP_SCAN 1
#endif
#ifndef REP_ATTN
#define REP_ATTN 1
#endif
#ifndef REP_SYNC
#define REP_SYNC 0
#endif
constexpr int T_ = 8192, D_ = 2048, FF_ = 5632;
constexpr int LDS_BYTES = 136 * 1024;
constexpr float EPS = 1e-6f;
constexpr size_t SZ_WGU = (size_t)11264 * 2048 * 2, SZ_WD = (size_t)2048 * 5632 * 2, SZ_WIN = (size_t)6144 * 2048 * 2, SZ_WSQ = (size_t)2048 * 2048 * 2, SZ_WKV = (size_t)4096 * 2048 * 2, SZ_WBA = (size_t)16 * 2048 * 2;
constexpr size_t OFF_WGU = 0;
constexpr size_t OFF_WD = OFF_WGU + 4 * SZ_WGU;
constexpr size_t OFF_WIN = OFF_WD + 4 * SZ_WD;
constexpr size_t OFF_WOUT = OFF_WIN + 2 * SZ_WIN;
constexpr size_t OFF_WXQ = OFF_WOUT + 2 * SZ_WSQ;
constexpr size_t OFF_WXO = OFF_WXQ + 2 * SZ_WSQ;
constexpr size_t OFF_WKV = OFF_WXO + 2 * SZ_WSQ;
constexpr size_t OFF_WBA = OFF_WKV + 2 * SZ_WKV;
constexpr size_t OFF_H = OFF_WBA + 2 * SZ_WBA;
constexpr size_t OFF_MEMH = OFF_H + (size_t)T_ * D_ * 2;
constexpr size_t OFF_BIG = OFF_MEMH + (size_t)2 * 1024 * 2048 * 2;
constexpr size_t OFF_F = OFF_BIG + (size_t)T_ * 6144 * 2;
constexpr size_t OFF_Y = OFF_F + (size_t)T_ * D_ * 4;
constexpr size_t OFF_AO = OFF_Y + (size_t)T_ * D_ * 2;
constexpr size_t OFF_KB = OFF_AO + (size_t)T_ * D_ * 2;
constexpr size_t OFF_VT = OFF_KB + (size_t)2 * 1024 * 2048 * 2;
constexpr size_t OFF_DW = OFF_VT + (size_t)2 * 1024 * 2048 * 2;
constexpr size_t OFF_DU = OFF_DW + (size_t)1024 * 64 * 128 * 2;
constexpr size_t OFF_DQG = OFF_DU + (size_t)1024 * 64 * 128 * 4;
constexpr size_t OFF_DKT = OFF_DQG + (size_t)1024 * 64 * 128 * 2;
constexpr size_t OFF_DA = OFF_DKT + (size_t)1024 * 64 * 128 * 2;
constexpr size_t OFF_DEG = OFF_DA + (size_t)1024 * 64 * 64 * 2;
constexpr size_t OFF_BG = OFF_DEG + 4096;
constexpr size_t OFF_STATS = OFF_BG + (size_t)T_ * 16 * 4;
constexpr size_t OFF_BAR = OFF_STATS + (size_t)2 * T_ * 32 * 4;
constexpr size_t BAR_BYTES = 16384;
constexpr size_t WS_END = OFF_BAR + BAR_BYTES;

#define XB_TMO      128
#define XB_XCNT(j)  (256  + 64 * (j))
#define XB_XSUB(j)  (1280 + 64 * (j))
#define XB_XGEN(j)  (2304 + 64 * (j))
#define XB_TOP      3328
#define XB_TOPGEN   3392
#define XCD_BAR_WORDS 3456
#define XB_SPIN_CAP (1u << 18)

__device__ __forceinline__ unsigned xb_ld(unsigned* p)              { return __hip_atomic_load(p, __ATOMIC_RELAXED, __HIP_MEMORY_SCOPE_AGENT); }
__device__ __forceinline__ unsigned xb_add(unsigned* p, unsigned v) { return __hip_atomic_fetch_add(p, v, __ATOMIC_RELAXED, __HIP_MEMORY_SCOPE_AGENT); }
__device__ __forceinline__ unsigned xb_xcc_id() { return (unsigned)__builtin_amdgcn_s_getreg((3 << 11) | 20) & 0xFu; }
#define XB_SPIN(cond, bar) do { unsigned _sp = 0; while (cond) { __builtin_amdgcn_s_sleep(1); \
    if ((++_sp & 255u) == 0u) { if (xb_ld(&(bar)[XB_TMO])) break; if (_sp > XB_SPIN_CAP) { atomicAdd(&(bar)[XB_TMO], 1u); break; } } } } while (0)

struct XcdBarrier {
    unsigned* bar; unsigned x;
    volatile LAS unsigned* st;
};

__device__ __forceinline__ XcdBarrier xcd_barrier_post(unsigned* bar, volatile LAS unsigned* st) {
    XcdBarrier b; b.bar = bar; b.x = xb_xcc_id(); b.st = st;
    if (threadIdx.x == 0) (void)xb_add(&bar[XB_XCNT(b.x)], 1u);
    return b;
}
__device__ __forceinline__ void xcd_barrier_complete(unsigned* bar, unsigned x, unsigned& nloc, unsigned& nx) {
    const unsigned G = gridDim.x * gridDim.y * gridDim.z;
    unsigned sum, cnt, mine, sp = 0u;
    for (;;) {
        sum = 0u; cnt = 0u; mine = 0u;
#pragma unroll
        for (unsigned j = 0; j < 16; ++j) { const unsigned c = xb_ld(&bar[XB_XCNT(j)]); sum += c; cnt += (c > 0u) ? 1u : 0u; mine = (j == x) ? c : mine; }
        if (sum == G) break;
        __builtin_amdgcn_s_sleep(1);
        if ((++sp & 255u) == 0u) { if (xb_ld(&bar[XB_TMO])) break; if (sp > XB_SPIN_CAP) { atomicAdd(&bar[XB_TMO], 1u); break; } }
    }
    nloc = mine > 0u ? mine : 1u; nx = cnt > 0u ? cnt : 1u;
}

__device__ __forceinline__ void xcd_barrier(const XcdBarrier& b) {
    asm volatile("s_waitcnt vmcnt(0)" ::: "memory");
    __syncthreads();
    if (threadIdx.x == 0) {
        unsigned* bar = b.bar;
        __builtin_amdgcn_s_waitcnt(0);
        unsigned nloc = b.st[0], nx = b.st[1];
        if (nloc == 0u) { xcd_barrier_complete(bar, b.x, nloc, nx); b.st[0] = nloc; b.st[1] = nx; }
        const unsigned old = xb_add(&bar[XB_XSUB(b.x)], 1u);
        const unsigned gen = old / nloc;
        if (old + 1u == (gen + 1u) * nloc) {
            __builtin_amdgcn_fence(__ATOMIC_RELEASE, "agent");
            asm volatile("s_waitcnt vmcnt(0)" ::: "memory");
            const unsigned og = xb_add(&bar[XB_TOP], 1u);
            const unsigned tg = og / nx;
            if (og + 1u == (tg + 1u) * nx) xb_add(&bar[XB_TOPGEN], 1u);
            else XB_SPIN(xb_ld(&bar[XB_TOPGEN]) == tg, bar);
            __builtin_amdgcn_fence(__ATOMIC_ACQUIRE, "agent");
            xb_add(&bar[XB_XGEN(b.x)], 1u);
            asm volatile("s_waitcnt vmcnt(0)" ::: "memory");
        } else {
            XB_SPIN(xb_ld(&bar[XB_XGEN(b.x)]) == gen, bar);
            __builtin_amdgcn_fence(__ATOMIC_ACQUIRE, "agent");
            asm volatile("s_waitcnt vmcnt(0)" ::: "memory");
        }
    }
    __syncthreads();
}


struct P { const float* in[28]; float* out; unsigned char* ws; };

__device__ __forceinline__ float bf2f(unsigned v) { return __uint_as_float(v << 16); }
__device__ __forceinline__ unsigned pk2(float a, float b) { return pg8::cvt_pk_bf16(a, b); }
__device__ __forceinline__ float wave_sum(float v) {
#pragma unroll
    for (int o = 32; o >= 1; o >>= 1) v += __shfl_xor(v, o);
    return v; }
__device__ __forceinline__ bf16x8 mk8(unsigned a, unsigned b, unsigned c, unsigned d) { u32x4 w; w.x = a; w.y = b; w.z = c; w.w = d; return __builtin_bit_cast(bf16x8, w); }
#define MFMA16(a, b, c) __builtin_amdgcn_mfma_f32_16x16x32_bf16((a), (b), (c), 0, 0, 0)
#define MFMA4F(a, b, c) __builtin_amdgcn_mfma_f32_16x16x4f32((a), (b), (c), 0, 0, 0)

__device__ __forceinline__ void rowpass(int nrows, const float* f, const float* gpost, float scale, const float* xin, float* xout, const float* gpre, bf16_t* h) {
    const int tid_ = opaque_tid(); const int lane = tid_ & 63, wv = tid_ >> 6;
    const int gw = blockIdx.x * 8 + wv, nw = gridDim.x * 8;
    for (int r = gw; r < nrows; r += nw) {
        const size_t base = (size_t)r * 2048 + lane * 4;
        f32x4 xv[8];
#pragma unroll
        for (int i = 0; i < 8; ++i) xv[i] = *(const f32x4*)(xin + base + i * 256);
        if (f) {
            f32x4 fv[8]; float ss = 0.f;
#pragma unroll
            for (int i = 0; i < 8; ++i) { fv[i] = *(const f32x4*)(f + base + i * 256); ss += fv[i].x * fv[i].x + fv[i].y * fv[i].y + fv[i].z * fv[i].z + fv[i].w * fv[i].w; }
            ss = wave_sum(ss);
            const float rs = rsqrtf(ss * (1.0f / 2048.0f) + EPS) * scale;
#pragma unroll
            for (int i = 0; i < 8; ++i) { const f32x4 g = *(const f32x4*)(gpost + lane * 4 + i * 256); xv[i] += fv[i] * rs * g; }
        }
        if (xout) {
#pragma unroll
            for (int i = 0; i < 8; ++i) *(f32x4*)(xout + base + i * 256) = xv[i];
        }
        if (h) {
            float ss = 0.f;
#pragma unroll
            for (int i = 0; i < 8; ++i) ss += xv[i].x * xv[i].x + xv[i].y * xv[i].y + xv[i].z * xv[i].z + xv[i].w * xv[i].w;
            ss = wave_sum(ss);
            const float rs = rsqrtf(ss * (1.0f / 2048.0f) + EPS);
#pragma unroll
            for (int i = 0; i < 8; ++i) { const f32x4 g = *(const f32x4*)(gpre + lane * 4 + i * 256); const f32x4 o = xv[i] * rs * g;
                u32x2 w; w.x = pk2(o.x, o.y); w.y = pk2(o.z, o.w); *(u32x2*)(h + base + i * 256) = w; }
        }
    }
}

struct ConvJob { const float* W; bf16_t* Wt; int ldw, K, k0, n0, sc0; };
__device__ __forceinline__ ConvJob conv_decode(const P& p, int g) {
    const int l = g / 12544; int r = g - l * 12544; ConvJob j; int tilesN; bool il = false;
    if (r < 2816) { j.W = p.in[3] + (size_t)l * 2048 * 11264; j.ldw = 11264; j.K = 2048; j.Wt = (bf16_t*)(p.ws + OFF_WGU + (size_t)(0 * 2 + l) * SZ_WGU); tilesN = 176; il = true; }
    else if (r < 4224) { r -= 2816; j.W = p.in[4] + (size_t)l * 5632 * 2048; j.ldw = 2048; j.K = 5632; j.Wt = (bf16_t*)(p.ws + OFF_WD + (size_t)(0 * 2 + l) * SZ_WD); tilesN = 32; }
    else if (r < 5760) { r -= 4224; j.W = p.in[7] + (size_t)l * 2048 * 6160; j.ldw = 6160; j.K = 2048; j.Wt = (bf16_t*)(p.ws + OFF_WIN + (size_t)l * SZ_WIN); tilesN = 96; }
    else if (r < 6272) { r -= 5760; j.W = p.in[16] + (size_t)l * 2048 * 2048; j.ldw = 2048; j.K = 2048; j.Wt = (bf16_t*)(p.ws + OFF_WOUT + (size_t)l * SZ_WSQ); tilesN = 32; }
    else if (r < 6784) { r -= 6272; j.W = p.in[20] + (size_t)l * 2048 * 2048; j.ldw = 2048; j.K = 2048; j.Wt = (bf16_t*)(p.ws + OFF_WXQ + (size_t)l * SZ_WSQ); tilesN = 32; }
    else if (r < 7808) { r -= 6784; j.W = p.in[21] + (size_t)l * 2048 * 4096; j.ldw = 4096; j.K = 2048; j.Wt = (bf16_t*)(p.ws + OFF_WKV + (size_t)l * SZ_WKV); tilesN = 64; }
    else if (r < 8320) { r -= 7808; j.W = p.in[22] + (size_t)l * 2048 * 2048; j.ldw = 2048; j.K = 2048; j.Wt = (bf16_t*)(p.ws + OFF_WXO + (size_t)l * SZ_WSQ); tilesN = 32; }
    else if (r < 11136) { r -= 8320; j.W = p.in[25] + (size_t)l * 2048 * 11264; j.ldw = 11264; j.K = 2048; j.Wt = (bf16_t*)(p.ws + OFF_WGU + (size_t)(1 * 2 + l) * SZ_WGU); tilesN = 176; il = true; }
    else { r -= 11136; j.W = p.in[26] + (size_t)l * 5632 * 2048; j.ldw = 2048; j.K = 5632; j.Wt = (bf16_t*)(p.ws + OFF_WD + (size_t)(1 * 2 + l) * SZ_WD); tilesN = 32; }
    const int kt = r / tilesN, nt = r - kt * tilesN; j.k0 = kt * 128; j.n0 = nt * 64;
    j.sc0 = il ? (((j.n0 >> 7) & 1) * 5632 + (j.n0 >> 8) * 128 + (j.n0 & 127)) : j.n0;
    return j;
}
__device__ __forceinline__ void phase0(LAS unsigned char* lds, const P& p) {
    const int tid = opaque_tid();
    LAS float* tl = (LAS float*)lds;
    const int c4 = (tid & 15) * 4, kr = tid >> 4;
    const int kg = tid & 15, nr = tid >> 4;
    constexpr int TOTAL = 2 * 12544;
#pragma unroll 1
    for (int rep_ = 0; rep_ < REP_CONV; ++rep_) {
    int g = blockIdx.x;
    f32x4 v[4]; ConvJob j;
    if (g < TOTAL) { j = conv_decode(p, g);
#pragma unroll
        for (int i = 0; i < 4; ++i) v[i] = *(const f32x4*)(j.W + (size_t)(j.k0 + kr + 32 * i) * j.ldw + j.sc0 + c4); }
    while (g < TOTAL) {
#pragma unroll
        for (int i = 0; i < 4; ++i) { const int k = kr + 32 * i; tl[(c4 + 0) * 129 + k] = v[i].x; tl[(c4 + 1) * 129 + k] = v[i].y; tl[(c4 + 2) * 129 + k] = v[i].z; tl[(c4 + 3) * 129 + k] = v[i].w; }
        __syncthreads();
        const ConvJob cj = j; const int gn = g + gridDim.x;
        if (gn < TOTAL) { j = conv_decode(p, gn);
#pragma unroll
            for (int i = 0; i < 4; ++i) v[i] = *(const f32x4*)(j.W + (size_t)(j.k0 + kr + 32 * i) * j.ldw + j.sc0 + c4); }
#pragma unroll
        for (int i = 0; i < 2; ++i) { const int n = nr + 32 * i; const LAS float* s = tl + n * 129 + kg * 8;
            u32x4 w; w.x = pk2(s[0], s[1]); w.y = pk2(s[2], s[3]); w.z = pk2(s[4], s[5]); w.w = pk2(s[6], s[7]);
            *(u32x4*)(cj.Wt + (size_t)(cj.n0 + n) * cj.K + cj.k0 + kg * 8) = w; }
        __syncthreads();
        g = gn;
    }
    }
    { const int gt = blockIdx.x * 512 + tid, gn = gridDim.x * 512;
      for (int e = gt; e < 2 * 16 * 2048; e += gn) { const int l = e >> 15, n = (e >> 11) & 15, k = e & 2047;
          ((bf16_t*)(p.ws + OFF_WBA))[e] = (bf16_t)(pk2(p.in[7][((size_t)l * 2048 + k) * 6160 + 6144 + n], 0.f) & 0xffffu); }
    }
    rowpass(T_, nullptr, nullptr, 0.f, p.in[0], p.out, p.in[2], (bf16_t*)(p.ws + OFF_H));
    rowpass(1024, nullptr, nullptr, 0.f, p.in[1], nullptr, p.in[19], (bf16_t*)(p.ws + OFF_MEMH));
    rowpass(1024, nullptr, nullptr, 0.f, p.in[1], nullptr, p.in[19] + 2048, (bf16_t*)(p.ws + OFF_MEMH) + (size_t)1024 * 2048);
}

__device__ __forceinline__ void wy_unit(LAS unsigned char* lds, const P& p, int l, int uid) {
    const int tid = opaque_tid(), lane = tid & 63, wv = tid >> 6;
    const int bh = uid >> 5, n = uid & 31, b = bh >> 3, hh = bh & 7;
    const int t0 = b * 2048 + n * 64;
    LAS float* sq = (LAS float*)lds; LAS float* sk = sq + 64 * 132; LAS float* sv = sk + 64 * 132; LAS float* sL = sv + 64 * 132;
    LAS float* sgc = sL + 64 * 64; LAS float* sbeta = sgc + 64; LAS float* segc = sbeta + 64;
    const bf16_t* proj = (const bf16_t*)(p.ws + OFF_BIG);
    const float* cw = p.in[8] + (size_t)l * 4 * 3072;
    bf16_t* DW = (bf16_t*)(p.ws + OFF_DW); float* DU = (float*)(p.ws + OFF_DU); bf16_t* DQG = (bf16_t*)(p.ws + OFF_DQG);
    bf16_t* DKT = (bf16_t*)(p.ws + OFF_DKT); bf16_t* DA = (bf16_t*)(p.ws + OFF_DA); float* DEG = (float*)(p.ws + OFF_DEG);
    {
        const int d = tid & 127, tb = (tid >> 7) * 16; const int tseq = n * 64 + tb;
#pragma unroll
        for (int which = 0; which < 3; ++which) {
            const int ch = which * 1024 + hh * 128 + d;
            const float w0 = cw[ch], w1 = cw[3072 + ch], w2 = cw[2 * 3072 + ch], w3 = cw[3 * 3072 + ch];
            const bf16_t* src = proj + (size_t)(t0 + tb) * 6144 + 2048 + ch;
            float x0 = tseq >= 3 ? bf2f(*(src - 3 * 6144)) : 0.f, x1 = tseq >= 2 ? bf2f(*(src - 2 * 6144)) : 0.f, x2 = tseq >= 1 ? bf2f(*(src - 6144)) : 0.f;
            LAS float* dst = (which == 0 ? sq : (which == 1 ? sk : sv)) + tb * 132 + d;
#pragma unroll 4
            for (int i = 0; i < 16; ++i) { const float x3 = bf2f(src[(size_t)i * 6144]); float y = w0 * x0 + w1 * x1 + w2 * x2 + w3 * x3; y = silu_f(y); dst[i * 132] = y; x0 = x1; x1 = x2; x2 = x3; }
        }
    }
    if (wv == 0) {
        const float* bg = (const float*)(p.ws + OFF_BG) + (size_t)(t0 + lane) * 16;
        const float beta = bg[hh]; float g = bg[8 + hh];
#pragma unroll
        for (int o = 1; o < 64; o <<= 1) { const float t = __shfl_up(g, o); if (lane >= o) g += t; }
        sgc[lane] = g; sbeta[lane] = beta; segc[lane] = __expf(g);
    }
    __syncthreads();
    for (int i = 0; i < 8; ++i) { const int t = wv * 8 + i;
        { const float a0 = sq[t * 132 + lane], a1 = sq[t * 132 + 64 + lane]; const float r = rsqrtf(wave_sum(a0 * a0 + a1 * a1) + EPS) * 0.08838834764831845f; sq[t * 132 + lane] = a0 * r; sq[t * 132 + 64 + lane] = a1 * r; }
        { const float a0 = sk[t * 132 + lane], a1 = sk[t * 132 + 64 + lane]; const float r = rsqrtf(wave_sum(a0 * a0 + a1 * a1) + EPS); sk[t * 132 + lane] = a0 * r; sk[t * 132 + 64 + lane] = a1 * r; }
    }
    __syncthreads();
    {
        const int ti = wv >> 1, sp = wv & 1, r16 = lane & 15, g4 = lane >> 4;
        f32x4 akk0 = {0.f, 0.f, 0.f, 0.f}, akk1 = akk0, aqk0 = akk0, aqk1 = akk0;
        if (2 * sp <= ti) {
#pragma unroll 2
            for (int st = 0; st < 8; ++st) { const int dofs = st * 16 + g4 * 4;
                const f32x4 kt = *(const LAS f32x4*)(sk + (16 * ti + r16) * 132 + dofs), qt = *(const LAS f32x4*)(sq + (16 * ti + r16) * 132 + dofs);
                const f32x4 ks0 = *(const LAS f32x4*)(sk + (32 * sp + r16) * 132 + dofs), ks1 = *(const LAS f32x4*)(sk + (32 * sp + 16 + r16) * 132 + dofs);
#pragma unroll
                for (int c = 0; c < 4; ++c) { akk0 = MFMA4F(kt[c], ks0[c], akk0); aqk0 = MFMA4F(qt[c], ks0[c], aqk0); akk1 = MFMA4F(kt[c], ks1[c], akk1); aqk1 = MFMA4F(qt[c], ks1[c], aqk1); } }
        }
#pragma unroll
        for (int e = 0; e < 2; ++e) { const f32x4 akk = e ? akk1 : akk0, aqk = e ? aqk1 : aqk0; const int s = 32 * sp + 16 * e + r16; const float gs = sgc[s];
#pragma unroll
            for (int r = 0; r < 4; ++r) { const int t = 16 * ti + 4 * g4 + r; const float dec = (s <= t) ? __expf(fminf(sgc[t] - gs, 0.f)) : 0.f;
                sL[t * 64 + s] = (s < t) ? sbeta[t] * akk[r] * dec : 0.f;
                DA[((size_t)uid * 64 + t) * 64 + s] = (bf16_t)(pk2(aqk[r] * dec, 0.f) & 0xffffu); } }
    }
    __syncthreads();
    {
        { const int d2 = (tid & 63) * 2, tr = tid >> 6;
#pragma unroll 4
          for (int i = 0; i < 8; ++i) { const int t = tr + 8 * i; const float e = segc[t]; const f32x2 qv = *(const LAS f32x2*)(sq + t * 132 + d2); *(unsigned*)(DQG + ((size_t)uid * 64 + t) * 128 + d2) = pk2(qv.x * e, qv.y * e); } }
        { const int t2 = (tid & 31) * 2, dr = tid >> 5; const float gl = sgc[63]; const float e0 = __expf(gl - sgc[t2]), e1 = __expf(gl - sgc[t2 + 1]);
#pragma unroll 4
          for (int i = 0; i < 8; ++i) { const int d = dr + 16 * i; *(unsigned*)(DKT + ((size_t)uid * 128 + d) * 64 + t2) = pk2(sk[t2 * 132 + d] * e0, sk[(t2 + 1) * 132 + d] * e1); } }
        if (tid == 0) DEG[uid] = segc[63];
    }
    __syncthreads();
    if (tid < 256) {
        const bool isu = tid < 128; LAS float* col = isu ? (sv + tid) : (sk + (tid - 128));
#pragma unroll 1
        for (int bi = 0; bi < 4; ++bi) {
            float a[16];
#pragma unroll
            for (int r = 0; r < 16; ++r) { const int t = 16 * bi + r; a[r] = col[t * 132] * sbeta[t] * (isu ? 1.0f : segc[t]); }
            const LAS float* Lb = sL + (16 * bi) * 64;
#pragma unroll 1
            for (int sg = 0; sg < 4 * bi; ++sg) {
                const float s0 = col[(4 * sg + 0) * 132], s1 = col[(4 * sg + 1) * 132], s2 = col[(4 * sg + 2) * 132], s3 = col[(4 * sg + 3) * 132];
#pragma unroll
                for (int r = 0; r < 16; ++r) { const f32x4 lv = *(const LAS f32x4*)(Lb + r * 64 + 4 * sg); a[r] -= lv.x * s0 + lv.y * s1 + lv.z * s2 + lv.w * s3; }
            }
#pragma unroll
            for (int r = 1; r < 16; ++r) {
#pragma unroll
                for (int j = 0; j < (r + 3) / 4; ++j) { const f32x4 lv = *(const LAS f32x4*)(Lb + r * 64 + 16 * bi + 4 * j);
                    if (4 * j + 0 < r) a[r] -= lv.x * a[4 * j + 0]; if (4 * j + 1 < r) a[r] -= lv.y * a[4 * j + 1]; if (4 * j + 2 < r) a[r] -= lv.z * a[4 * j + 2]; if (4 * j + 3 < r) a[r] -= lv.w * a[4 * j + 3]; }
            }
#pragma unroll
            for (int r = 0; r < 16; ++r) col[(16 * bi + r) * 132] = a[r];
        }
    }
    __syncthreads();
    {
        const int d2 = (tid & 63) * 2, tr = tid >> 6;
#pragma unroll 4
        for (int i = 0; i < 8; ++i) { const int t = tr + 8 * i;
            *(f32x2*)(DU + ((size_t)uid * 64 + t) * 128 + d2) = *(const LAS f32x2*)(sv + t * 132 + d2);
            const f32x2 wv2 = *(const LAS f32x2*)(sk + t * 132 + d2); *(unsigned*)(DW + ((size_t)uid * 64 + t) * 128 + d2) = pk2(wv2.x, wv2.y); }
    }
    __syncthreads();
}

__device__ __forceinline__ void sgu_unit(LAS unsigned char* lds, const P& p, int l, int uid) {
    const int tid = opaque_tid(), lane = tid & 63, wv = tid >> 6, r16 = lane & 15, g4 = lane >> 4;
    const int hh = uid & 7, t0 = (uid >> 3) * 128;
    LAS bf16_t* vT = (LAS bf16_t*)lds;
    const bf16_t* proj = (const bf16_t*)(p.ws + OFF_BIG);
    const float* stats = (const float*)(p.ws + OFF_STATS) + (size_t)l * T_ * 32;
    const float* lng = p.in[13] + l * 1024 + hh * 128; const float* lnb = p.in[14] + l * 1024 + hh * 128;
    {
        const int s = tid & 127, dgb = tid >> 7;
        float su = 0.f, sqq = 0.f;
#pragma unroll
        for (int i = 0; i < 8; ++i) { const f32x4 pv = *(const f32x4*)(stats + (size_t)(t0 + s) * 32 + 4 * i); su += pv.x + pv.z; sqq += pv.y + pv.w; }
        const float mu = su * (1.0f / 1024.0f); const float var = fmaxf(sqq * (1.0f / 1024.0f) - mu * mu, 0.f); const float rs = rsqrtf(var + EPS);
#pragma unroll
        for (int i = 0; i < 4; ++i) { const int dg = dgb + 4 * i;
            const u32x4 raw = *(const u32x4*)(proj + (size_t)(t0 + s) * 6144 + 1024 + hh * 128 + dg * 8);
            const f32x4 ga = *(const f32x4*)(lng + dg * 8), gb = *(const f32x4*)(lng + dg * 8 + 4), ba = *(const f32x4*)(lnb + dg * 8), bb = *(const f32x4*)(lnb + dg * 8 + 4);
            float vv[8] = {bf2f(raw.x & 0xffffu), bf2f(raw.x >> 16), bf2f(raw.y & 0xffffu), bf2f(raw.y >> 16), bf2f(raw.z & 0xffffu), bf2f(raw.z >> 16), bf2f(raw.w & 0xffffu), bf2f(raw.w >> 16)};
            const float gg[8] = {ga.x, ga.y, ga.z, ga.w, gb.x, gb.y, gb.z, gb.w}, bbv[8] = {ba.x, ba.y, ba.z, ba.w, bb.x, bb.y, bb.z, bb.w};
#pragma unroll
            for (int e = 0; e < 8; ++e) vT[(dg * 8 + e) * 136 + s] = (bf16_t)(pk2((vv[e] - mu) * rs * gg[e] + bbv[e], 0.f) & 0xffffu); }
    }
    __syncthreads();
    const int t = 16 * wv + r16;
    const float* wm = p.in[11] + (((size_t)l * 8 + hh) * 128 + t) * 128;
    const int nkk = (16 * wv + 15) / 32 + 1;
    f32x4 acc[8];
#pragma unroll
    for (int i = 0; i < 8; ++i) acc[i] = (f32x4){0.f, 0.f, 0.f, 0.f};
    for (int kk = 0; kk < nkk; ++kk) { const int s0 = 32 * kk + 8 * g4;
        f32x4 w0 = *(const f32x4*)(wm + s0), w1 = *(const f32x4*)(wm + s0 + 4);
#pragma unroll
        for (int c = 0; c < 4; ++c) { if (s0 + c > t) w0[c] = 0.f; if (s0 + 4 + c > t) w1[c] = 0.f; }
        const bf16x8 af = mk8(pk2(w0.x, w0.y), pk2(w0.z, w0.w), pk2(w1.x, w1.y), pk2(w1.z, w1.w));
#pragma unroll
        for (int nt = 0; nt < 8; ++nt) { const bf16x8 bfr = *(const LAS bf16x8*)(vT + (16 * nt + r16) * 136 + s0); acc[nt] = MFMA16(bfr, af, acc[nt]); } }
    const float bias = p.in[12][((size_t)l * 8 + hh) * 128 + t];
    const bf16_t* gu = proj + (size_t)(t0 + t) * 6144 + hh * 128; bf16_t* yo = (bf16_t*)(p.ws + OFF_Y) + (size_t)(t0 + t) * 2048 + hh * 128;
#pragma unroll
    for (int nt = 0; nt < 8; ++nt) { const int d = 16 * nt + 4 * g4; const u32x2 gr = *(const u32x2*)(gu + d);
        u32x2 w; w.x = pk2(bf2f(gr.x & 0xffffu) * (acc[nt].x + bias), bf2f(gr.x >> 16) * (acc[nt].y + bias)); w.y = pk2(bf2f(gr.y & 0xffffu) * (acc[nt].z + bias), bf2f(gr.y >> 16) * (acc[nt].w + bias));
        *(u32x2*)(yo + d) = w; }
    __syncthreads();
}

__device__ __forceinline__ void scan_unit(LAS unsigned char* lds, const P& p, int bh, int sl) {
    const int tid = opaque_tid(), lane = tid & 63, wv = tid >> 6, r16 = lane & 15, g4 = lane >> 4;
    LAS bf16_t* ST = (LAS bf16_t*)lds;
    LAS bf16_t* VN = ST + 16 * 136;
    const int b = bh >> 3, hh = bh & 7, grp = wv >> 2, rt = wv & 3;
    const bf16_t* DW = (const bf16_t*)(p.ws + OFF_DW); const float* DU = (const float*)(p.ws + OFF_DU); const bf16_t* DQG = (const bf16_t*)(p.ws + OFF_DQG);
    const bf16_t* DKT = (const bf16_t*)(p.ws + OFF_DKT); const bf16_t* DA = (const bf16_t*)(p.ws + OFF_DA); const float* DEG = (const float*)(p.ws + OFF_DEG);
    float* O = (float*)(p.ws + OFF_F);
    for (int i = tid; i < 16 * 136 / 2; i += 512) ((LAS unsigned*)ST)[i] = 0u;
    f32x4 sacc = {0.f, 0.f, 0.f, 0.f};
    __syncthreads();
    const bf16_t* a1b = (grp == 0 ? DW : DQG) + ((size_t)(bh * 32) * 64 + 16 * rt + r16) * 128 + 8 * g4;
    const bf16_t* a3b = DKT + ((size_t)(bh * 32) * 128 + 16 * wv + r16) * 64 + 8 * g4;
    const bf16_t* a2b = DA + ((size_t)(bh * 32) * 64 + 16 * rt + r16) * 64 + 8 * g4;
    const float* upb = DU + ((size_t)(bh * 32) * 64 + 16 * rt + 4 * g4) * 128 + sl * 16 + r16;
    bf16x8 af[4], kf[2], aa[2]; f32x4 uu; float eg;
#define SCAN_LOAD(n_) do { const int n__ = (n_); \
        _Pragma("unroll") for (int kk = 0; kk < 4; ++kk) af[kk] = *(const bf16x8*)(a1b + (size_t)n__ * 64 * 128 + 32 * kk); \
        kf[0] = *(const bf16x8*)(a3b + (size_t)n__ * 128 * 64); kf[1] = *(const bf16x8*)(a3b + (size_t)n__ * 128 * 64 + 32); \
        aa[0] = *(const bf16x8*)(a2b + (size_t)n__ * 64 * 64); aa[1] = *(const bf16x8*)(a2b + (size_t)n__ * 64 * 64 + 32); \
        { const float* up = upb + (size_t)n__ * 64 * 128; uu = (f32x4){up[0], up[128], up[256], up[384]}; } \
        eg = DEG[bh * 32 + n__]; } while (0)
    SCAN_LOAD(0);
    for (int n = 0; n < 32; ++n) {
        bf16x8 caf[4] = {af[0], af[1], af[2], af[3]}, ckf[2] = {kf[0], kf[1]}, caa[2] = {aa[0], aa[1]}; const f32x4 cuu = uu; const float ceg = eg;
        if (n + 1 < 32) SCAN_LOAD(n + 1);
        f32x4 acc1 = {0.f, 0.f, 0.f, 0.f};
#pragma unroll
        for (int kk = 0; kk < 4; ++kk) { const bf16x8 bfr = *(const LAS bf16x8*)(ST + r16 * 136 + 32 * kk + 8 * g4); acc1 = MFMA16(caf[kk], bfr, acc1); }
        if (grp == 0) { const f32x4 vn = cuu - acc1; u32x2 w; w.x = pk2(vn.x, vn.y); w.y = pk2(vn.z, vn.w); *(LAS u32x2*)(VN + r16 * 72 + 16 * rt + 4 * g4) = w; }
        __syncthreads();
        const bf16x8 v0 = *(const LAS bf16x8*)(VN + r16 * 72 + 8 * g4), v1 = *(const LAS bf16x8*)(VN + r16 * 72 + 32 + 8 * g4);
        if (grp == 1) { acc1 = MFMA16(caa[0], v0, acc1); acc1 = MFMA16(caa[1], v1, acc1);
            float* op = O + ((size_t)(b * 2048 + n * 64 + 16 * rt + 4 * g4)) * 1024 + hh * 128 + sl * 16 + r16;
            op[0] = acc1.x; op[1024] = acc1.y; op[2048] = acc1.z; op[3072] = acc1.w; }
        sacc *= ceg;
        sacc = MFMA16(ckf[0], v0, sacc); sacc = MFMA16(ckf[1], v1, sacc);
        { u32x2 w; w.x = pk2(sacc.x, sacc.y); w.y = pk2(sacc.z, sacc.w); *(LAS u32x2*)(ST + r16 * 136 + 16 * wv + 4 * g4) = w; }
        __syncthreads();
    }
#undef SCAN_LOAD
}

__device__ __forceinline__ void attn_unit(LAS unsigned char* lds, const P& p, int l, int uid) {
    const int tid = opaque_tid(), lane = tid & 63, wv = tid >> 6, r16 = lane & 15, g4 = lane >> 4;
    const int b = uid >> 6, hh = (uid >> 4) & 3, qt = uid & 15; const int t0 = b * 2048 + qt * 128;
    const bf16_t* kbase = (const bf16_t*)(p.ws + OFF_KB) + (size_t)l * 1024 * 2048 + (size_t)(b * 256) * 2048 + hh * 512;
    const bf16_t* vbase = (const bf16_t*)(p.ws + OFF_VT) + (size_t)l * 1024 * 2048 + (size_t)((b * 4 + hh) * 512) * 256;
    const bf16_t* qrow = (const bf16_t*)(p.ws + OFF_Y) + (size_t)(t0 + 16 * wv + r16) * 2048 + hh * 512 + 8 * g4;
    bf16_t* orow = (bf16_t*)(p.ws + OFF_AO) + (size_t)(t0 + 16 * wv + r16) * 2048 + hh * 512 + 4 * g4;
    u32x4 pre[4];
#define ATT_LOADK(dc) do { _Pragma("unroll") for (int i = 0; i < 4; ++i) { const int pi = tid + 512 * i; pre[i] = *(const u32x4*)(kbase + (size_t)(pi >> 3) * 2048 + (dc) * 64 + (pi & 7) * 8); } } while (0)
#define ATT_WRITEK(buf) do { _Pragma("unroll") for (int i = 0; i < 4; ++i) { const int pi = tid + 512 * i; *(LAS u32x4*)((buf) + (pi >> 3) * 144 + (pi & 7) * 16) = pre[i]; } } while (0)
#define ATT_LOADV(dc) do { _Pragma("unroll") for (int i = 0; i < 4; ++i) { const int pi = tid + 512 * i; pre[i] = *(const u32x4*)(vbase + (size_t)((dc) * 64 + (pi >> 5)) * 256 + (pi & 31) * 8); } } while (0)
#define ATT_WRITEV(buf) do { _Pragma("unroll") for (int i = 0; i < 4; ++i) { const int pi = tid + 512 * i; *(LAS u32x4*)((buf) + (pi >> 5) * 528 + (pi & 31) * 16) = pre[i]; } } while (0)
    f32x4 sacc[16];
#pragma unroll
    for (int i = 0; i < 16; ++i) sacc[i] = (f32x4){0.f, 0.f, 0.f, 0.f};
    ATT_LOADK(0); ATT_WRITEK(lds); __syncthreads();
    for (int dc = 0; dc < 8; ++dc) {
        LAS unsigned char* cur = lds + (dc & 1) * 36864; LAS unsigned char* nxt = lds + ((dc + 1) & 1) * 36864;
        if (dc < 7) ATT_LOADK(dc + 1); else ATT_LOADV(0);
        const bf16x8 qf0 = *(const bf16x8*)(qrow + dc * 64), qf1 = *(const bf16x8*)(qrow + dc * 64 + 32);
#pragma unroll
        for (int n = 0; n < 16; ++n) { const LAS unsigned char* rp = cur + (16 * n + r16) * 144 + g4 * 16;
            const bf16x8 kf0 = *(const LAS bf16x8*)rp, kf1 = *(const LAS bf16x8*)(rp + 64);
            sacc[n] = MFMA16(kf0, qf0, sacc[n]); sacc[n] = MFMA16(kf1, qf1, sacc[n]); }
        if (dc < 7) ATT_WRITEK(nxt); else ATT_WRITEV(nxt);
        __syncthreads();
    }
    float mx = -3.0e38f;
#pragma unroll
    for (int n = 0; n < 16; ++n) mx = fmaxf(mx, fmaxf(fmaxf(sacc[n].x, sacc[n].y), fmaxf(sacc[n].z, sacc[n].w)));
    mx = fmaxf(mx, __shfl_xor(mx, 16)); mx = fmaxf(mx, __shfl_xor(mx, 32));
    float sum = 0.f;
#pragma unroll
    for (int n = 0; n < 16; ++n) {
#pragma unroll
        for (int r = 0; r < 4; ++r) { const float e = exp2f((sacc[n][r] - mx) * 1.4426950408889634f); sacc[n][r] = e; sum += e; } }
    sum += __shfl_xor(sum, 16); sum += __shfl_xor(sum, 32);
    const float inv = 1.0f / sum;
    bf16x8 pf[8];
#pragma unroll
    for (int kk = 0; kk < 8; ++kk) pf[kk] = mk8(pk2(sacc[2 * kk].x, sacc[2 * kk].y), pk2(sacc[2 * kk].z, sacc[2 * kk].w), pk2(sacc[2 * kk + 1].x, sacc[2 * kk + 1].y), pk2(sacc[2 * kk + 1].z, sacc[2 * kk + 1].w));
    for (int dc = 0; dc < 8; ++dc) {
        LAS unsigned char* cur = lds + (dc & 1) * 36864; LAS unsigned char* nxt = lds + ((dc + 1) & 1) * 36864;
        if (dc < 7) ATT_LOADV(dc + 1);
        f32x4 oacc[4];
#pragma unroll
        for (int nd = 0; nd < 4; ++nd) { oacc[nd] = (f32x4){0.f, 0.f, 0.f, 0.f}; const LAS unsigned char* rp = cur + (16 * nd + r16) * 528 + g4 * 8;
#pragma unroll
            for (int kk = 0; kk < 8; ++kk) { const u32x2 lo = *(const LAS u32x2*)(rp + kk * 64), hi = *(const LAS u32x2*)(rp + kk * 64 + 32);
                oacc[nd] = MFMA16(mk8(lo.x, lo.y, hi.x, hi.y), pf[kk], oacc[nd]); } }
#pragma unroll
        for (int nd = 0; nd < 4; ++nd) { u32x2 w; w.x = pk2(oacc[nd].x * inv, oacc[nd].y * inv); w.y = pk2(oacc[nd].z * inv, oacc[nd].w * inv); *(u32x2*)(orow + dc * 64 + 16 * nd) = w; }
        if (dc < 7) ATT_WRITEV(nxt);
        __syncthreads();
    }
#undef ATT_LOADK
#undef ATT_WRITEK
#undef ATT_LOADV
#undef ATT_WRITEV
}

#if defined(DBG_STOP)
__device__ __forceinline__ float dbg_get(const void* p, int isf32, size_t idx) { return isf32 ? ((const float*)p)[idx] : bf2f(((const bf16_t*)p)[idx]); }
__device__ __forceinline__ void dbg_dump(float* out, const void* a, int af32, size_t lda, size_t a0, const void* b, int bf32, size_t ldb, size_t b0) {
    for (size_t i = (size_t)blockIdx.x * 512 + threadIdx.x; i < (size_t)T_ * 2048; i += (size_t)gridDim.x * 512) { const size_t t = i >> 11, c = i & 2047;
        out[i] = c < 1024 ? dbg_get(a, af32, t * lda + a0 + c) : dbg_get(b, bf32, t * ldb + b0 + (c - 1024)); } }
#endif
__global__ void __launch_bounds__(512, 2) mk_fwd(P p) {
    extern __shared__ __attribute__((aligned(16))) unsigned char lds_raw[];
    LAS unsigned char* lds = (LAS unsigned char*)lds_raw;
    cg::grid_group grid = cg::this_grid();
#define GSYNC_CG() do { asm volatile("s_waitcnt vmcnt(0) lgkmcnt(0)" ::: "memory"); __builtin_amdgcn_fence(__ATOMIC_RELEASE, "agent"); grid.sync(); __builtin_amdgcn_fence(__ATOMIC_ACQUIRE, "agent"); } while (0)
#define GSYNC() xcd_barrier(xbar)
    if (threadIdx.x < 4) ((LAS unsigned*)(lds + LDS_BYTES - 16))[threadIdx.x] = 0u;
    __syncthreads();
    const XcdBarrier xbar = xcd_barrier_post((unsigned*)(p.ws + OFF_BAR), (volatile LAS unsigned*)(lds + LDS_BYTES - 16));
    const int G = gridDim.x, bx = blockIdx.x;
    unsigned char* ws = p.ws;
    bf16_t* H = (bf16_t*)(ws + OFF_H); bf16_t* BIG = (bf16_t*)(ws + OFF_BIG); float* F = (float*)(ws + OFF_F); bf16_t* Y = (bf16_t*)(ws + OFF_Y); bf16_t* AO = (bf16_t*)(ws + OFF_AO);

    phase0(lds, p);
    GSYNC_CG();
#pragma unroll 1
    for (int l = 0; l < 2; ++l) {
#pragma unroll 1
        for (int ffn = 0; ffn < 2; ++ffn) {
            if (ffn == 1) {
                {
                    pg8::Gemm g{H, (const bf16_t*)(ws + OFF_WIN + (size_t)l * SZ_WIN), T_, 6144, 2048}; pg8::StaticOrder S; S.init(T_, 6144, G, bx);
                    pg8::EpiIn E{BIG, (float*)(ws + OFF_STATS) + (size_t)l * T_ * 32};
                    _Pragma("unroll 1") for (int rep_ = 0; rep_ < REP_GEMM; ++rep_) pg8::gemm_phase<pg8::EpiIn, pg8::StaticOrder>(lds, g, S, E, nullptr);
                    const float* alog = p.in[9] + l * 8; const float* dtb = p.in[10] + l * 8; float* BG = (float*)(ws + OFF_BG);
                    const int tid = opaque_tid(), lane = tid & 63, wv = tid >> 6, r16 = lane & 15, g4 = lane >> 4;
                    for (int rp = bx; rp < 256; rp += G) {
                        const int rt = 2 * rp + (wv >> 2), kq = wv & 3;
                        const bf16_t* ap = H + (size_t)(16 * rt + r16) * 2048 + 512 * kq + 8 * g4;
                        const bf16_t* bp = (const bf16_t*)(ws + OFF_WBA) + (size_t)l * 16 * 2048 + (size_t)r16 * 2048 + 512 * kq + 8 * g4;
                        f32x4 acc = {0.f, 0.f, 0.f, 0.f};
#pragma unroll 4
                        for (int kk = 0; kk < 16; ++kk) acc = MFMA16(*(const bf16x8*)(ap + 32 * kk), *(const bf16x8*)(bp + 32 * kk), acc);
                        LAS f32x4* red = (LAS f32x4*)lds; red[wv * 64 + lane] = acc; __syncthreads();
                        if (kq == 0) { const f32x4 s = red[wv * 64 + lane] + red[(wv + 1) * 64 + lane] + red[(wv + 2) * 64 + lane] + red[(wv + 3) * 64 + lane];
#pragma unroll
                            for (int r = 0; r < 4; ++r) { const float v = s[r]; float o;
                                if (r16 < 8) o = 1.0f / (1.0f + __expf(-v));
                                else { const float a = v + dtb[r16 - 8]; const float sp = a > 20.f ? a : log1pf(__expf(a)); o = -__expf(alog[r16 - 8]) * sp; }
                                BG[(size_t)(16 * rt + 4 * g4 + r) * 16 + r16] = o; } }
                        __syncthreads();
                    }
                }
                GSYNC();
#if defined(DBG_STOP)
                if (l == 0 && DBG_STOP == 5) { dbg_dump(p.out, BIG, 0, 6144, 0, BIG, 0, 6144, 1024); return; }
                if (l == 0 && DBG_STOP == 6) { dbg_dump(p.out, BIG, 0, 6144, 2048, BIG, 0, 6144, 3072); return; }
                if (l == 0 && DBG_STOP == 7) { dbg_dump(p.out, BIG, 0, 6144, 4096, BIG, 0, 6144, 5120); return; }
                if (l == 0 && DBG_STOP == 12) { dbg_dump(p.out, ws + OFF_BG, 1, 16, 0, ws + OFF_STATS, 1, 32, 0); return; }
#endif
                _Pragma("unroll 1") for (int rep_ = 0; rep_ < REP_WY; ++rep_) for (int u = bx; u < 1536; u += G) { if (u < 1024) wy_unit(lds, p, l, u); else sgu_unit(lds, p, l, u - 1024); }
                GSYNC();
#if defined(DBG_STOP)
                if (l == 0 && DBG_STOP == 8) { dbg_dump(p.out, Y, 0, 2048, 0, ws + OFF_DU, 1, 1024, 0); return; }
                if (l == 0 && DBG_STOP == 9) { dbg_dump(p.out, ws + OFF_DW, 0, 1024, 0, ws + OFF_DQG, 0, 1024, 0); return; }
                if (l == 0 && DBG_STOP == 10) { dbg_dump(p.out, ws + OFF_DKT, 0, 1024, 0, ws + OFF_DKT, 0, 1024, 0); return; }
                if (l == 0 && DBG_STOP == 14) { dbg_dump(p.out, ws + OFF_DA, 0, 256, (size_t)T_ * 256, ws + OFF_DEG, 1, 0, 0); return; }
                if (l == 0 && DBG_STOP == 13) { dbg_dump(p.out, ws + OFF_DA, 0, 256, 0, ws + OFF_DA, 0, 256, 0); return; }
#endif
                _Pragma("unroll 1") for (int rep_ = 0; rep_ < REP_SCAN; ++rep_) for (int u = bx; u < 256; u += G) scan_unit(lds, p, (u & 7) + 8 * (u >> 6), (u >> 3) & 7);
                GSYNC();
#if defined(DBG_STOP)
                if (l == 0 && DBG_STOP == 11) { dbg_dump(p.out, F, 1, 1024, 0, F, 1, 1024, 0); return; }
#endif
                {
                    const int tid = opaque_tid(), lane = tid & 63, wv = tid >> 6;
                    const float* O = F; const float* dnw = p.in[15] + l * 128; const float w0 = dnw[lane * 2], w1 = dnw[lane * 2 + 1];
                    for (int t = bx * 8 + wv; t < T_; t += G * 8) {
#pragma unroll
                        for (int hh = 0; hh < 8; ++hh) { const f32x2 ov = *(const f32x2*)(O + (size_t)t * 1024 + hh * 128 + lane * 2);
                            const float rs = rsqrtf(wave_sum(ov.x * ov.x + ov.y * ov.y) * (1.0f / 128.0f) + EPS);
                            const unsigned zr = *(const unsigned*)(BIG + (size_t)t * 6144 + 5120 + hh * 128 + lane * 2);
                            *(unsigned*)(Y + (size_t)t * 2048 + 1024 + hh * 128 + lane * 2) = pk2(ov.x * rs * w0 * pg8::silu_f(bf2f(zr & 0xffffu)), ov.y * rs * w1 * pg8::silu_f(bf2f(zr >> 16))); }
                    }
                }
                GSYNC();
                { pg8::Gemm g{Y, (const bf16_t*)(ws + OFF_WOUT + (size_t)l * SZ_WSQ), T_, 2048, 2048}; pg8::StaticOrder S; S.init(T_, 2048, G, bx); pg8::EpiF32 E{F, 2048, nullptr};
                  _Pragma("unroll 1") for (int rep_ = 0; rep_ < REP_GEMM; ++rep_) pg8::gemm_phase<pg8::EpiF32, pg8::StaticOrder>(lds, g, S, E, nullptr); }
                GSYNC();
                rowpass(T_, F, p.in[17] + l * 2048, 1.0f, p.out, p.out, p.in[18] + l * 2048, H);
#if defined(DBG_STOP)
                if (DBG_STOP == 2 && l == 0) return;
#endif
                GSYNC();
                { pg8::Gemm g{H, (const bf16_t*)(ws + OFF_WXQ + (size_t)l * SZ_WSQ), T_, 2048, 2048}; pg8::StaticOrder S; S.init(T_, 2048, G, bx); pg8::EpiScaleBf16 E{Y, 2048, 0.04419417382415922f};
                  _Pragma("unroll 1") for (int rep_ = 0; rep_ < REP_GEMM; ++rep_) pg8::gemm_phase<pg8::EpiScaleBf16, pg8::StaticOrder>(lds, g, S, E, nullptr); }
                GSYNC();
                _Pragma("unroll 1") for (int rep_ = 0; rep_ < REP_ATTN; ++rep_) for (int u = bx; u < 256; u += G) attn_unit(lds, p, l, u);
                GSYNC();
                { pg8::Gemm g{AO, (const bf16_t*)(ws + OFF_WXO + (size_t)l * SZ_WSQ), T_, 2048, 2048}; pg8::StaticOrder S; S.init(T_, 2048, G, bx); pg8::EpiF32 E{F, 2048, nullptr};
                  _Pragma("unroll 1") for (int rep_ = 0; rep_ < REP_GEMM; ++rep_) pg8::gemm_phase<pg8::EpiF32, pg8::StaticOrder>(lds, g, S, E, nullptr); }
                GSYNC();
                rowpass(T_, F, p.in[23] + l * 2048, 1.0f, p.out, p.out, p.in[24] + l * 2048, H);
#if defined(DBG_STOP)
                if (DBG_STOP == 3 && l == 0) return;
#endif
                GSYNC();
            }
            { pg8::Gemm g{H, (const bf16_t*)(ws + OFF_WGU + (size_t)(ffn * 2 + l) * SZ_WGU), T_, 11264, 2048}; pg8::StaticOrder S; S.init(T_, 11264, G, bx); pg8::EpiSwiglu E{BIG};
              _Pragma("unroll 1") for (int rep_ = 0; rep_ < REP_GEMM; ++rep_) pg8::gemm_phase<pg8::EpiSwiglu, pg8::StaticOrder>(lds, g, S, E, nullptr);
              if (l == 0 && ffn == 0) {
#pragma unroll 1
                  for (int ll = 0; ll < 2; ++ll) {
                      pg8::Gemm g2{(const bf16_t*)(ws + OFF_MEMH) + (size_t)ll * 1024 * 2048, (const bf16_t*)(ws + OFF_WKV + (size_t)ll * SZ_WKV), 1024, 4096, 2048};
                      pg8::TailOrder S2{G, bx, 64 * ll, 64, 16};
                      pg8::EpiKV E2{(bf16_t*)(ws + OFF_KB) + (size_t)ll * 1024 * 2048, (bf16_t*)(ws + OFF_VT) + (size_t)ll * 1024 * 2048};
                      _Pragma("unroll 1") for (int rep_ = 0; rep_ < REP_GEMM; ++rep_) pg8::gemm_phase<pg8::EpiKV, pg8::TailOrder>(lds, g2, S2, E2, nullptr); } } }
            GSYNC();
            { pg8::Gemm g{BIG, (const bf16_t*)(ws + OFF_WD + (size_t)(ffn * 2 + l) * SZ_WD), T_, 2048, 5632}; pg8::StaticOrder S; S.init(T_, 2048, G, bx); pg8::EpiF32 E{F, 2048, nullptr};
              _Pragma("unroll 1") for (int rep_ = 0; rep_ < REP_GEMM; ++rep_) pg8::gemm_phase<pg8::EpiF32, pg8::StaticOrder>(lds, g, S, E, nullptr); }
            GSYNC();
            {   const float* gpost = (ffn == 0 ? p.in[5] : p.in[27]) + l * 2048;
                const float* gpre = ffn == 0 ? p.in[6] + l * 2048 : (l == 0 ? p.in[2] + 2048 : nullptr);
                rowpass(T_, F, gpost, 0.5f, p.out, p.out, gpre, gpre ? H : nullptr); }
            _Pragma("unroll 1") for (int rep_ = 0; rep_ < REP_ROW; ++rep_) { GSYNC(); rowpass(T_, F, p.in[5], 0.0f, p.out, p.out, p.in[6], (bf16_t*)(ws + OFF_AO)); }
            _Pragma("unroll 1") for (int rep_ = 0; rep_ < REP_SYNC; ++rep_) { GSYNC(); }
#if defined(DBG_STOP)
            if (DBG_STOP == 1 && l == 0 && ffn == 0) return;
            if (DBG_STOP == 4 && l == 0 && ffn == 1) return;
#endif
            if (!(l == 1 && ffn == 1)) GSYNC();
        }
    }
}

extern "C" void kernel_launch(void* const* d_in, const int* in_sizes, int n_in, void* d_out, int out_size, void* d_ws, size_t ws_size, hipStream_t stream) {
    static int grid = 0;
    if (grid == 0) {
        int dev = 0, cus = 0, per_cu = 0;
        if (hipGetDevice(&dev) != hipSuccess || hipDeviceGetAttribute(&cus, hipDeviceAttributeMultiprocessorCount, dev) != hipSuccess) { fprintf(stderr, "kernel_launch: device query failed\n"); grid = -1; return; }
        if (hipFuncSetAttribute((const void*)mk_fwd, hipFuncAttributeMaxDynamicSharedMemorySize, LDS_BYTES) != hipSuccess) { fprintf(stderr, "kernel_launch: hipFuncSetAttribute failed\n"); grid = -1; return; }
        if (hipOccupancyMaxActiveBlocksPerMultiprocessor(&per_cu, (const void*)mk_fwd, 512, LDS_BYTES) != hipSuccess || per_cu < 1) fprintf(stderr, "kernel_launch: occupancy query says %d blocks per CU\n", per_cu);
        (void)hipGetLastError();
        if (n_in != 28 || ws_size < WS_END || cus != 256) { fprintf(stderr, "kernel_launch: unexpected setup n_in %d ws %zu (need %zu) cus %d\n", n_in, ws_size, (size_t)WS_END, cus); }
        grid = 256;
    }
    if (grid < 0) return;
    P a{};
    for (int i = 0; i < 28; ++i) a.in[i] = (const float*)d_in[i];
    a.out = (float*)d_out; a.ws = (unsigned char*)d_ws;
    if (hipMemsetAsync((unsigned char*)d_ws + OFF_BAR, 0, BAR_BYTES, stream) != hipSuccess) { fprintf(stderr, "kernel_launch: memset failed\n"); return; }
    void* args[] = {&a};
    const hipError_t e = hipLaunchCooperativeKernel((const void*)mk_fwd, dim3(grid), dim3(512), args, LDS_BYTES, stream);
    if (e != hipSuccess) fprintf(stderr, "kernel_launch: cooperative launch failed: %s\n", hipGetErrorString(e));
}
```

```cpp
#include <hip/hip_runtime.h>
#include <hip/hip_cooperative_groups.h>
#include <cstdio>
namespace cg = cooperative_groups;
__device__ __forceinline__ int opaque_tid() { int t = threadIdx.x; asm volatile("" : "+v"(t)); return t; }
namespace pg8 {
#define PG8_LAS __attribute__((address_space(3)))
typedef unsigned short bf16_t;
typedef short bf16x8 __attribute__((ext_vector_type(8)));
typedef float f32x4 __attribute__((ext_vector_type(4)));
typedef unsigned u32x4 __attribute__((ext_vector_type(4)));
constexpr int BM = 256, BK = 64, HALF = 128, HTB = HALF * BK * 2  , STAGE_BYTES = 8 * HTB, NXCD = 8, WGM = 8;

__host__ __device__ __forceinline__ int lds_byte(int r, int c) { const int st = (r >> 4) * 2 + (c >> 5), rr = r & 15, cc = c & 31, ob = rr * 64 + cc * 2; return st * 1024 + (ob ^ (((ob >> 9) & 1) << 5)); }
__host__ __device__ __forceinline__ void stage_rc(int b, int& R, int& C) { const int st = b / 1024, sb = b % 1024, swz = sb ^ (((sb >> 9) & 1) << 5); R = (st >> 1) * 16 + swz / 64; C = (st & 1) * 32 + (swz % 64) / 2; }
__host__ __device__ __forceinline__ int perm32(int rho) { const int n = rho >> 4, i = rho & 15; return 8 * (i >> 2) + 4 * n + (i & 3); }

struct Unit { int pm, pn; };
struct Gemm { const bf16_t* A; const bf16_t* Bt; int M, N, K; };

struct StaticOrder {
    int nM, nN, nwg, G, c;
    __host__ __device__ void init(int M, int N, int G_, int c_) { nM = M / BM; nN = N / BM; nwg = nM * nN; G = G_; c = c_; }
    __host__ __device__ bool next(int i, Unit& u) const {
        const long L = (long)i * G + c; if (L >= nwg) return false;
        int wgid = (int)L; { const int q = nwg / NXCD, r = nwg % NXCD, xcd = wgid % NXCD, off = wgid / NXCD; wgid = (xcd < r ? xcd * (q + 1) : r * (q + 1) + (xcd - r) * q) + off; }
        const int nig = WGM * nN, gid = wgid / nig, fm = gid * WGM, gsz = (nM - fm) < WGM ? (nM - fm) : WGM;
        u.pm = fm + ((wgid % nig) % gsz); u.pn = (wgid % nig) / gsz; return true;
    }
    __device__ __forceinline__ void a_ready(const Unit&) const {}
    __device__ __forceinline__ void done(const Unit&) const {}
};
typedef __bf16 bf16v2_t __attribute__((ext_vector_type(2)));
typedef float f32x2_cv __attribute__((ext_vector_type(2)));
__device__ __forceinline__ unsigned cvt_pk_bf16(float lo, float hi) { const f32x2_cv v = {lo, hi}; return __builtin_bit_cast(unsigned, __builtin_convertvector(v, bf16v2_t)); }
typedef float f32x2 __attribute__((ext_vector_type(2)));
__device__ __forceinline__ f32x2 gelu_pk(f32x2 v) {
    const f32x2 av = __builtin_elementwise_abs(v), d = av * 0.2316418882f + 1.0f;
    f32x2 t; t.x = __builtin_amdgcn_rcpf(d.x); t.y = __builtin_amdgcn_rcpf(d.y);
    f32x2 q = t * 0.5307027145f + (-0.7265760135f); q = q * t + 0.7107068705f; q = q * t + (-0.142248368f); q = q * t + 0.127414796f; q = q * t;
    const f32x2 s = (v * v) * (-0.72134752044f);
    f32x2 e; e.x = __builtin_amdgcn_exp2f(s.x); e.y = __builtin_amdgcn_exp2f(s.y);
    const f32x2 m = v * (q * e), r = v - m;
    f32x2 o; o.x = v.x < 0.f ? m.x : r.x; o.y = v.y < 0.f ? m.y : r.y; return o;
}

struct EpiF32 {
    static constexpr bool PERM = false, AFTER_DRAIN = false;
    float* C; int ldc; const float* bias;
    __device__ __forceinline__ void operator()(const f32x4 (&acc)[2][2][4][2], const Unit& u, int wr, int wc, int fr, int fq) const {
        const int row0 = u.pm * BM + wr * 64 + fr, col0 = u.pn * BM + wc * 32 + 4 * fq;
        f32x4 bv[2][2];
#pragma unroll
        for (int bj = 0; bj < 2; ++bj)
#pragma unroll
            for (int n = 0; n < 2; ++n) bv[bj][n] = bias ? *(const f32x4*)(bias + col0 + bj * HALF + n * 16) : (f32x4){0.f, 0.f, 0.f, 0.f};
#pragma unroll
        for (int ai = 0; ai < 2; ++ai)
#pragma unroll
            for (int m = 0; m < 4; ++m) { float* rowp = C + (size_t)(row0 + ai * HALF + m * 16) * ldc + col0;
#pragma unroll
                for (int bj = 0; bj < 2; ++bj)
#pragma unroll
                    for (int n = 0; n < 2; ++n) *(f32x4*)(rowp + bj * HALF + n * 16) = acc[ai][bj][m][n] + bv[bj][n]; }
    }
};
typedef unsigned u32x2 __attribute__((ext_vector_type(2)));
__device__ __forceinline__ float silu_f(float g) { return g * __builtin_amdgcn_rcpf(1.0f + __expf(-g)); }
struct EpiSwiglu {
    static constexpr bool PERM = true, AFTER_DRAIN = false;
    bf16_t* O;
    __device__ __forceinline__ void operator()(const f32x4 (&acc)[2][2][4][2], const Unit& u, int wr, int wc, int fr, int fq) const {
        const int row0 = u.pm * BM + wr * 64 + fr, col0 = u.pn * HALF + wc * 32 + 8 * fq;
#pragma unroll
        for (int ai = 0; ai < 2; ++ai)
#pragma unroll
            for (int m = 0; m < 4; ++m) { bf16_t* rowp = O + (size_t)(row0 + ai * HALF + m * 16) * 5632 + col0;
                const f32x4 g0 = acc[ai][0][m][0], g1 = acc[ai][0][m][1], u0 = acc[ai][1][m][0], u1 = acc[ai][1][m][1];
                f32x4 v0, v1;
#pragma unroll
                for (int j = 0; j < 4; ++j) { v0[j] = silu_f(g0[j]) * u0[j]; v1[j] = silu_f(g1[j]) * u1[j]; }
                u32x4 w; w.x = cvt_pk_bf16(v0[0], v0[1]); w.y = cvt_pk_bf16(v0[2], v0[3]); w.z = cvt_pk_bf16(v1[0], v1[1]); w.w = cvt_pk_bf16(v1[2], v1[3]);
                *(u32x4*)rowp = w; }
    }
};
struct EpiIn {
    static constexpr bool PERM = true, AFTER_DRAIN = false;
    bf16_t* O; float* stats;
    __device__ __forceinline__ void operator()(const f32x4 (&acc)[2][2][4][2], const Unit& u, int wr, int wc, int fr, int fq) const {
        const int row0 = u.pm * BM + wr * 64 + fr, col0 = u.pn * BM + wc * 32 + 8 * fq;
        const int mode = u.pn < 4 ? 1 : (u.pn < 8 ? 2 : 0);
#pragma unroll
        for (int ai = 0; ai < 2; ++ai)
#pragma unroll
            for (int m = 0; m < 4; ++m) { const int row = row0 + ai * HALF + m * 16; bf16_t* rowp = O + (size_t)row * 6144 + col0; float s = 0.f, q = 0.f;
#pragma unroll
                for (int bj = 0; bj < 2; ++bj) { f32x4 v0 = acc[ai][bj][m][0], v1 = acc[ai][bj][m][1];
                    if (mode) { f32x2 a = gelu_pk((f32x2){v0[0], v0[1]}), b = gelu_pk((f32x2){v0[2], v0[3]}), c = gelu_pk((f32x2){v1[0], v1[1]}), d = gelu_pk((f32x2){v1[2], v1[3]});
                        v0 = (f32x4){a.x, a.y, b.x, b.y}; v1 = (f32x4){c.x, c.y, d.x, d.y}; }
                    if (mode == 2) {
#pragma unroll
                        for (int j = 0; j < 4; ++j) { s += v0[j] + v1[j]; q += v0[j] * v0[j] + v1[j] * v1[j]; } }
                    u32x4 w; w.x = cvt_pk_bf16(v0[0], v0[1]); w.y = cvt_pk_bf16(v0[2], v0[3]); w.z = cvt_pk_bf16(v1[0], v1[1]); w.w = cvt_pk_bf16(v1[2], v1[3]);
                    *(u32x4*)(rowp + bj * HALF) = w; }
                if (mode == 2) { s += __shfl_xor(s, 16); s += __shfl_xor(s, 32); q += __shfl_xor(q, 16); q += __shfl_xor(q, 32);
                    if (fq == 0) *(f32x2*)(stats + ((size_t)row * 16 + (u.pn - 4) * 4 + wc) * 2) = (f32x2){s, q}; } }
    }
};
struct EpiScaleBf16 {
    static constexpr bool PERM = true, AFTER_DRAIN = false;
    bf16_t* O; int ldc; float scale;
    __device__ __forceinline__ void operator()(const f32x4 (&acc)[2][2][4][2], const Unit& u, int wr, int wc, int fr, int fq) const {
        const int row0 = u.pm * BM + wr * 64 + fr, col0 = u.pn * BM + wc * 32 + 8 * fq;
#pragma unroll
        for (int ai = 0; ai < 2; ++ai)
#pragma unroll
            for (int m = 0; m < 4; ++m) { bf16_t* rowp = O + (size_t)(row0 + ai * HALF + m * 16) * ldc + col0;
#pragma unroll
                for (int bj = 0; bj < 2; ++bj) { const f32x4 v0 = acc[ai][bj][m][0] * scale, v1 = acc[ai][bj][m][1] * scale;
                    u32x4 w; w.x = cvt_pk_bf16(v0[0], v0[1]); w.y = cvt_pk_bf16(v0[2], v0[3]); w.z = cvt_pk_bf16(v1[0], v1[1]); w.w = cvt_pk_bf16(v1[2], v1[3]);
                    *(u32x4*)(rowp + bj * HALF) = w; } }
    }
};
struct EpiKV {
    static constexpr bool PERM = true, AFTER_DRAIN = false;
    bf16_t* Kb; bf16_t* Vt;
    __device__ __forceinline__ void operator()(const f32x4 (&acc)[2][2][4][2], const Unit& u, int wr, int wc, int fr, int fq) const {
        const int row0 = u.pm * BM + wr * 64 + fr, col0 = u.pn * BM + wc * 32 + 8 * fq;
#pragma unroll
        for (int ai = 0; ai < 2; ++ai)
#pragma unroll
            for (int m = 0; m < 4; ++m) { const int row = row0 + ai * HALF + m * 16;
#pragma unroll
                for (int bj = 0; bj < 2; ++bj) { const f32x4 v0 = acc[ai][bj][m][0], v1 = acc[ai][bj][m][1]; const int col = col0 + bj * HALF;
                    if (u.pn < 8) { u32x4 w; w.x = cvt_pk_bf16(v0[0], v0[1]); w.y = cvt_pk_bf16(v0[2], v0[3]); w.z = cvt_pk_bf16(v1[0], v1[1]); w.w = cvt_pk_bf16(v1[2], v1[3]);
                        *(u32x4*)(Kb + (size_t)row * 2048 + col) = w; }
                    else { const int cc = col - 2048, hh = cc >> 9, d = cc & 511, bb = row >> 8, mm = row & 255;
                        bf16_t* vp = Vt + ((size_t)((bb * 4 + hh) * 512 + d)) * 256 + mm;
#pragma unroll
                        for (int j = 0; j < 4; ++j) { vp[(size_t)j * 256] = (bf16_t)(cvt_pk_bf16(v0[j], 0.f) & 0xffffu); vp[(size_t)(4 + j) * 256] = (bf16_t)(cvt_pk_bf16(v1[j], 0.f) & 0xffffu); } } } }
    }
};
struct TailOrder {
    int G, c, off, n, nN;
    __device__ bool next(int i, Unit& u) const { if (i > 0) return false; const int idx = (G - 1 - c) - off; if (idx < 0 || idx >= n) return false; u.pm = idx / nN; u.pn = idx % nN; return true; }
    __device__ __forceinline__ void a_ready(const Unit&) const {}
    __device__ __forceinline__ void done(const Unit&) const {}
};
template <class Epi, class Sched, bool STAMP = false>
__device__ __forceinline__ void gemm_phase(PG8_LAS unsigned char* lds, const Gemm g, const Sched& S, const Epi& E, unsigned long long* stamps) {
    const int tid = opaque_tid(), wid = __builtin_amdgcn_readfirstlane(tid >> 6), lane = tid & 63, wr = wid >> 2, wc = wid & 3, fr = lane & 15, fq = lane >> 4;
    const int K = g.K, nt = K / BK;
    int ts_lo = 0, ts_hi = 0, nts = 0; const unsigned long long rt_entry = STAMP ? (unsigned long long)wall_clock64() : 0ull;
#define PG8_STAMP() do { if (STAMP && wid == 0 && nts < 64) { const unsigned long long _c = (unsigned long long)clock64(); \
        ts_lo = (lane == nts) ? (int)(unsigned)_c : ts_lo; ts_hi = (lane == nts) ? (int)(unsigned)(_c >> 32) : ts_hi; ++nts; } } while (0)
    PG8_STAMP();
    unsigned voffA[2], voffB[2];
#pragma unroll
    for (int i = 0; i < 2; ++i) { int R, C; stage_rc(tid * 16 + i * 8192, R, C); const int Rb = Epi::PERM ? ((R & ~31) + perm32(R & 31)) : R;
        voffA[i] = (unsigned)(R * K + C) * 2u; voffB[i] = (unsigned)(Rb * K + C) * 2u; }
    const size_t kstep = (size_t)(BK * 2);
    const size_t hstep = (size_t)HALF * K * 2;
    const size_t tstep = 2 * hstep;
    const unsigned ldsw = (unsigned)wid * 1024u;
    const int aoff = lds_byte(wr * 64 + fr, fq * 8), boff = lds_byte(wc * 32 + fr, fq * 8);
#define PG8_SA(b, h) (((b) * 2 + (h)) * HTB)
#define PG8_SB(b, h) ((4 + (b) * 2 + (h)) * HTB)
#define PG8_STAGE(bufoff, gbase, voff) do { _Pragma("unroll") for (int _i = 0; _i < 2; ++_i) \
        __builtin_amdgcn_global_load_lds((const unsigned*)((const char*)(gbase) + (voff)[_i]), (PG8_LAS unsigned*)(lds + (bufoff) + ldsw + _i * 8192), 16, 0, 0); } while (0)
#define PG8_LDA(dst, b, h) do { _Pragma("unroll") for (int m = 0; m < 4; ++m) _Pragma("unroll") for (int k = 0; k < 2; ++k) dst[m][k] = *(const PG8_LAS bf16x8*)(lds + PG8_SA(b, h) + aoff + m * 2048 + k * 1024); } while (0)
#define PG8_LDB(dst, b, h) do { _Pragma("unroll") for (int n = 0; n < 2; ++n) _Pragma("unroll") for (int k = 0; k < 2; ++k) dst[n][k] = *(const PG8_LAS bf16x8*)(lds + PG8_SB(b, h) + boff + n * 2048 + k * 1024); } while (0)
#define PG8_MMA(ai, bj, At, Bt) do { __builtin_amdgcn_s_setprio(1); _Pragma("unroll") for (int m = 0; m < 4; ++m) _Pragma("unroll") for (int n = 0; n < 2; ++n) _Pragma("unroll") for (int k = 0; k < 2; ++k) \
        acc[ai][bj][m][n] = __builtin_amdgcn_mfma_f32_16x16x32_bf16(Bt[n][k], At[m][k], acc[ai][bj][m][n], 0, 0, 0); __builtin_amdgcn_s_setprio(0); } while (0)
#define PG8_WAIT_V(n) asm volatile("s_waitcnt vmcnt(" #n ")" ::: "memory")
#define PG8_WAIT_L(n) asm volatile("s_waitcnt lgkmcnt(" #n ")" ::: "memory")
#define PG8_BAR __builtin_amdgcn_s_barrier()
#define PG8_SCHED __builtin_amdgcn_sched_barrier(0)
    Unit cur, nxt; int ui = 0;
    if (!S.next(0, cur)) return;
    f32x4 acc[2][2][4][2];
#pragma unroll
    for (int a = 0; a < 2; ++a)
#pragma unroll
        for (int b = 0; b < 2; ++b)
#pragma unroll
            for (int m = 0; m < 4; ++m)
#pragma unroll
                for (int n = 0; n < 2; ++n) acc[a][b][m][n] = (f32x4){0.f, 0.f, 0.f, 0.f};
    bf16x8 At[4][2], B0[2][2], B1[2][2];
    const char* cA = (const char*)g.A + (size_t)cur.pm * tstep; const char* cB = (const char*)g.Bt + (size_t)cur.pn * tstep;
    S.a_ready(cur);
    PG8_STAGE(PG8_SB(0, 0), cB, voffB); PG8_STAGE(PG8_SA(0, 0), cA, voffA); PG8_STAGE(PG8_SB(0, 1), cB + hstep, voffB); PG8_STAGE(PG8_SA(0, 1), cA + hstep, voffA);
    if (wr == 1) PG8_BAR;
    PG8_WAIT_V(4); PG8_BAR;
    PG8_STAGE(PG8_SB(1, 0), cB + kstep, voffB); PG8_STAGE(PG8_SA(1, 0), cA + kstep, voffA); PG8_STAGE(PG8_SB(1, 1), cB + hstep + kstep, voffB);
    PG8_WAIT_V(6); PG8_BAR;
    PG8_STAMP();
    for (;;) {
        const bool has_next = S.next(ui + 1, nxt);
        const char* nA = has_next ? (const char*)g.A + (size_t)nxt.pm * tstep : cA; const char* nB = has_next ? (const char*)g.Bt + (size_t)nxt.pn * tstep : cB;
        for (int t = 0; t < nt; t += 2) {
            const bool last = (t == nt - 2);
            const char* a1 = cA + (size_t)(t + 1) * kstep;
            const char* a2 = last ? nA : cA + (size_t)(t + 2) * kstep; const char* b2 = last ? nB : cB + (size_t)(t + 2) * kstep;
            const char* a3 = a2 + kstep; const char* b3 = b2 + kstep;
            if (last && has_next) S.a_ready(nxt);
            PG8_LDB(B0, 0, 0); PG8_SCHED; PG8_LDA(At, 0, 0); PG8_STAGE(PG8_SA(1, 1), a1 + hstep, voffA);
            PG8_WAIT_L(8); PG8_BAR; PG8_WAIT_L(0); PG8_MMA(0, 0, At, B0); PG8_BAR; PG8_SCHED;
            PG8_LDB(B1, 0, 1); PG8_STAGE(PG8_SB(0, 0), b2, voffB);
            PG8_BAR; PG8_WAIT_L(0); PG8_MMA(0, 1, At, B1); PG8_BAR;
            PG8_LDA(At, 0, 1); PG8_STAGE(PG8_SA(0, 0), a2, voffA);
            PG8_BAR; PG8_WAIT_L(0); PG8_MMA(1, 0, At, B0); PG8_BAR; PG8_SCHED;
            PG8_STAGE(PG8_SB(0, 1), b2 + hstep, voffB);
            PG8_WAIT_V(6); PG8_BAR; PG8_MMA(1, 1, At, B1); PG8_BAR;
            PG8_LDB(B0, 1, 0); PG8_SCHED; PG8_LDA(At, 1, 0); PG8_STAGE(PG8_SA(0, 1), a2 + hstep, voffA);
            PG8_WAIT_L(8); PG8_BAR; PG8_WAIT_L(0); PG8_MMA(0, 0, At, B0); PG8_BAR; PG8_SCHED;
            PG8_LDB(B1, 1, 1); PG8_STAGE(PG8_SB(1, 0), b3, voffB);
            PG8_BAR; PG8_WAIT_L(0); PG8_MMA(0, 1, At, B1); PG8_BAR;
            PG8_LDA(At, 1, 1); PG8_STAGE(PG8_SA(1, 0), a3, voffA);
            PG8_BAR; PG8_WAIT_L(0); PG8_MMA(1, 0, At, B0); PG8_BAR; PG8_SCHED;
            PG8_STAGE(PG8_SB(1, 1), b3 + hstep, voffB);
            PG8_WAIT_V(6); PG8_BAR; PG8_MMA(1, 1, At, B1); PG8_BAR;
        }
        PG8_STAMP();
        if constexpr (!Epi::AFTER_DRAIN) { E(acc, cur, wr, wc, fr, fq); S.done(cur); }
        PG8_STAMP();
        if (!has_next) break;
#pragma unroll
        for (int a = 0; a < 2; ++a)
#pragma unroll
            for (int b = 0; b < 2; ++b)
#pragma unroll
                for (int m = 0; m < 4; ++m)
#pragma unroll
                    for (int n = 0; n < 2; ++n) acc[a][b][m][n] = (f32x4){0.f, 0.f, 0.f, 0.f};
        cur = nxt; cA = nA; cB = nB; ++ui;
    }
    PG8_WAIT_V(0);
    if (wr == 0) PG8_BAR;
    PG8_BAR;
    if constexpr (Epi::AFTER_DRAIN) { E.fused(acc, cur, wr, wc, fr, fq, lds, wid, lane); S.done(cur); }
    PG8_STAMP();
    if (STAMP && wid == 0) { stamps[lane] = lane < nts ? (((unsigned long long)(unsigned)ts_hi << 32) | (unsigned)ts_lo) : 0ull;
        if (lane == 62) stamps[62] = rt_entry; if (lane == 63) stamps[63] = (unsigned long long)wall_clock64(); }
#undef PG8_STAMP
#undef PG8_SA
#undef PG8_SB
#undef PG8_STAGE
#undef PG8_LDA
#undef PG8_LDB
#undef PG8_MMA
#undef PG8_WAIT_V
#undef PG8_WAIT_L
#undef PG8_BAR
#undef PG8_SCHED
}
}
using pg8::silu_f; using pg8::bf16_t; using pg8::bf16x8; using pg8::f32x4; using pg8::f32x2; using pg8::u32x4; using pg8::u32x2; using pg8::cvt_pk_bf16;
#define LAS __attribute__((address_space(3)))
#ifndef REP_CONV
#define REP_CONV 1
#endif
#ifndef REP_GEMM
#define REP_GEMM 1
#endif
#ifndef REP_ROW
#define REP_ROW 0
#endif
#ifndef REP_WY
#define REP_WY 1
#endif
#ifndef REP_SCAN
#define REP_SCAN 1
#endif
#ifndef REP_ATTN
#define REP_ATTN 1
#endif
#ifndef REP_SYNC
#define REP_SYNC 0
#endif
constexpr int T_ = 8192, D_ = 2048, FF_ = 5632;
constexpr int LDS_BYTES = 136 * 1024;
constexpr float EPS = 1e-6f;
constexpr size_t SZ_WGU = (size_t)11264 * 2048 * 2, SZ_WD = (size_t)2048 * 5632 * 2, SZ_WIN = (size_t)6144 * 2048 * 2, SZ_WSQ = (size_t)2048 * 2048 * 2, SZ_WKV = (size_t)4096 * 2048 * 2, SZ_WBA = (size_t)16 * 2048 * 2;
constexpr size_t OFF_WGU = 0;
constexpr size_t OFF_WD = OFF_WGU + 4 * SZ_WGU;
constexpr size_t OFF_WIN = OFF_WD + 4 * SZ_WD;
constexpr size_t OFF_WOUT = OFF_WIN + 2 * SZ_WIN;
constexpr size_t OFF_WXQ = OFF_WOUT + 2 * SZ_WSQ;
constexpr size_t OFF_WXO = OFF_WXQ + 2 * SZ_WSQ;
constexpr size_t OFF_WKV = OFF_WXO + 2 * SZ_WSQ;
constexpr size_t OFF_WBA = OFF_WKV + 2 * SZ_WKV;
constexpr size_t OFF_H = OFF_WBA + 2 * SZ_WBA;
constexpr size_t OFF_MEMH = OFF_H + (size_t)T_ * D_ * 2;
constexpr size_t OFF_BIG = OFF_MEMH + (size_t)2 * 1024 * 2048 * 2;
constexpr size_t OFF_F = OFF_BIG + (size_t)T_ * 6144 * 2;
constexpr size_t OFF_Y = OFF_F + (size_t)T_ * D_ * 4;
constexpr size_t OFF_AO = OFF_Y + (size_t)T_ * D_ * 2;
constexpr size_t OFF_KB = OFF_AO + (size_t)T_ * D_ * 2;
constexpr size_t OFF_VT = OFF_KB + (size_t)2 * 1024 * 2048 * 2;
constexpr size_t OFF_DW = OFF_VT + (size_t)2 * 1024 * 2048 * 2;
constexpr size_t OFF_DU = OFF_DW + (size_t)1024 * 64 * 128 * 2;
constexpr size_t OFF_DQG = OFF_DU + (size_t)1024 * 64 * 128 * 4;
constexpr size_t OFF_DKT = OFF_DQG + (size_t)1024 * 64 * 128 * 2;
constexpr size_t OFF_DA = OFF_DKT + (size_t)1024 * 64 * 128 * 2;
constexpr size_t OFF_DEG = OFF_DA + (size_t)1024 * 64 * 64 * 2;
constexpr size_t OFF_BG = OFF_DEG + 4096;
constexpr size_t OFF_STATS = OFF_BG + (size_t)T_ * 16 * 4;
constexpr size_t OFF_BAR = OFF_STATS + (size_t)2 * T_ * 32 * 4;
constexpr size_t BAR_BYTES = 16384;
constexpr size_t WS_END = OFF_BAR + BAR_BYTES;

#define XB_TMO      128
#define XB_XCNT(j)  (256  + 64 * (j))
#define XB_XSUB(j)  (1280 + 64 * (j))
#define XB_XGEN(j)  (2304 + 64 * (j))
#define XB_TOP      3328
#define XB_TOPGEN   3392
#define XCD_BAR_WORDS 3456
#define XB_SPIN_CAP (1u << 18)

__device__ __forceinline__ unsigned xb_ld(unsigned* p)              { return __hip_atomic_load(p, __ATOMIC_RELAXED, __HIP_MEMORY_SCOPE_AGENT); }
__device__ __forceinline__ unsigned xb_add(unsigned* p, unsigned v) { return __hip_atomic_fetch_add(p, v, __ATOMIC_RELAXED, __HIP_MEMORY_SCOPE_AGENT); }
__device__ __forceinline__ unsigned xb_xcc_id() { return (unsigned)__builtin_amdgcn_s_getreg((3 << 11) | 20) & 0xFu; }
#define XB_SPIN(cond, bar) do { unsigned _sp = 0; while (cond) { __builtin_amdgcn_s_sleep(1); \
    if ((++_sp & 255u) == 0u) { if (xb_ld(&(bar)[XB_TMO])) break; if (_sp > XB_SPIN_CAP) { atomicAdd(&(bar)[XB_TMO], 1u); break; } } } } while (0)

struct XcdBarrier {
    unsigned* bar; unsigned x;
    volatile LAS unsigned* st;
};

__device__ __forceinline__ XcdBarrier xcd_barrier_post(unsigned* bar, volatile LAS unsigned* st) {
    XcdBarrier b; b.bar = bar; b.x = xb_xcc_id(); b.st = st;
    if (threadIdx.x == 0) (void)xb_add(&bar[XB_XCNT(b.x)], 1u);
    return b;
}
__device__ __forceinline__ void xcd_barrier_complete(unsigned* bar, unsigned x, unsigned& nloc, unsigned& nx) {
    const unsigned G = gridDim.x * gridDim.y * gridDim.z;
    unsigned sum, cnt, mine, sp = 0u;
    for (;;) {
        sum = 0u; cnt = 0u; mine = 0u;
#pragma unroll
        for (unsigned j = 0; j < 16; ++j) { const unsigned c = xb_ld(&bar[XB_XCNT(j)]); sum += c; cnt += (c > 0u) ? 1u : 0u; mine = (j == x) ? c : mine; }
        if (sum == G) break;
        __builtin_amdgcn_s_sleep(1);
        if ((++sp & 255u) == 0u) { if (xb_ld(&bar[XB_TMO])) break; if (sp > XB_SPIN_CAP) { atomicAdd(&bar[XB_TMO], 1u); break; } }
    }
    nloc = mine > 0u ? mine : 1u; nx = cnt > 0u ? cnt : 1u;
}

__device__ __forceinline__ void xcd_barrier(const XcdBarrier& b) {
    asm volatile("s_waitcnt vmcnt(0)" ::: "memory");
    __syncthreads();
    if (threadIdx.x == 0) {
        unsigned* bar = b.bar;
        __builtin_amdgcn_s_waitcnt(0);
        unsigned nloc = b.st[0], nx = b.st[1];
        if (nloc == 0u) { xcd_barrier_complete(bar, b.x, nloc, nx); b.st[0] = nloc; b.st[1] = nx; }
        const unsigned old = xb_add(&bar[XB_XSUB(b.x)], 1u);
        const unsigned gen = old / nloc;
        if (old + 1u == (gen + 1u) * nloc) {
            __builtin_amdgcn_fence(__ATOMIC_RELEASE, "agent");
            asm volatile("s_waitcnt vmcnt(0)" ::: "memory");
            const unsigned og = xb_add(&bar[XB_TOP], 1u);
            const unsigned tg = og / nx;
            if (og + 1u == (tg + 1u) * nx) xb_add(&bar[XB_TOPGEN], 1u);
            else XB_SPIN(xb_ld(&bar[XB_TOPGEN]) == tg, bar);
            __builtin_amdgcn_fence(__ATOMIC_ACQUIRE, "agent");
            xb_add(&bar[XB_XGEN(b.x)], 1u);
            asm volatile("s_waitcnt vmcnt(0)" ::: "memory");
        } else {
            XB_SPIN(xb_ld(&bar[XB_XGEN(b.x)]) == gen, bar);
            __builtin_amdgcn_fence(__ATOMIC_ACQUIRE, "agent");
            asm volatile("s_waitcnt vmcnt(0)" ::: "memory");
        }
    }
    __syncthreads();
}


struct P { const float* in[28]; float* out; unsigned char* ws; };

__device__ __forceinline__ float bf2f(unsigned v) { return __uint_as_float(v << 16); }
__device__ __forceinline__ unsigned pk2(float a, float b) { return pg8::cvt_pk_bf16(a, b); }
__device__ __forceinline__ float wave_sum(float v) {
#pragma unroll
    for (int o = 32; o >= 1; o >>= 1) v += __shfl_xor(v, o);
    return v; }
__device__ __forceinline__ bf16x8 mk8(unsigned a, unsigned b, unsigned c, unsigned d) { u32x4 w; w.x = a; w.y = b; w.z = c; w.w = d; return __builtin_bit_cast(bf16x8, w); }
#define LDS_BAR() do { asm volatile("s_waitcnt lgkmcnt(0)" ::: "memory"); __builtin_amdgcn_s_barrier(); asm volatile("" ::: "memory"); } while (0)
#define MFMA16(a, b, c) __builtin_amdgcn_mfma_f32_16x16x32_bf16((a), (b), (c), 0, 0, 0)
#define MFMA4F(a, b, c) __builtin_amdgcn_mfma_f32_16x16x4f32((a), (b), (c), 0, 0, 0)

__device__ __forceinline__ void rowpass(int nrows, const float* f, const float* gpost, float scale, const float* xin, float* xout, const float* gpre, bf16_t* h) {
    const int tid_ = opaque_tid(); const int lane = tid_ & 63, wv = tid_ >> 6;
    const int gw = blockIdx.x * 8 + wv, nw = gridDim.x * 8;
    for (int r = gw; r < nrows; r += nw) {
        const size_t base = (size_t)r * 2048 + lane * 4;
        f32x4 xv[8];
#pragma unroll
        for (int i = 0; i < 8; ++i) xv[i] = *(const f32x4*)(xin + base + i * 256);
        if (f) {
            f32x4 fv[8]; float ss = 0.f;
#pragma unroll
            for (int i = 0; i < 8; ++i) { fv[i] = *(const f32x4*)(f + base + i * 256); ss += fv[i].x * fv[i].x + fv[i].y * fv[i].y + fv[i].z * fv[i].z + fv[i].w * fv[i].w; }
            ss = wave_sum(ss);
            const float rs = rsqrtf(ss * (1.0f / 2048.0f) + EPS) * scale;
#pragma unroll
            for (int i = 0; i < 8; ++i) { const f32x4 g = *(const f32x4*)(gpost + lane * 4 + i * 256); xv[i] += fv[i] * rs * g; }
        }
        if (xout) {
#pragma unroll
            for (int i = 0; i < 8; ++i) *(f32x4*)(xout + base + i * 256) = xv[i];
        }
        if (h) {
            float ss = 0.f;
#pragma unroll
            for (int i = 0; i < 8; ++i) ss += xv[i].x * xv[i].x + xv[i].y * xv[i].y + xv[i].z * xv[i].z + xv[i].w * xv[i].w;
            ss = wave_sum(ss);
            const float rs = rsqrtf(ss * (1.0f / 2048.0f) + EPS);
#pragma unroll
            for (int i = 0; i < 8; ++i) { const f32x4 g = *(const f32x4*)(gpre + lane * 4 + i * 256); const f32x4 o = xv[i] * rs * g;
                u32x2 w; w.x = pk2(o.x, o.y); w.y = pk2(o.z, o.w); *(u32x2*)(h + base + i * 256) = w; }
        }
    }
}

struct ConvJob { const float* W; bf16_t* Wt; int ldw, K, k0, n0, sc0; };
__device__ __forceinline__ ConvJob conv_decode(const P& p, int g) {
    const int l = g / 12544; int r = g - l * 12544; ConvJob j; int tilesN; bool il = false;
    if (r < 2816) { j.W = p.in[3] + (size_t)l * 2048 * 11264; j.ldw = 11264; j.K = 2048; j.Wt = (bf16_t*)(p.ws + OFF_WGU + (size_t)(0 * 2 + l) * SZ_WGU); tilesN = 176; il = true; }
    else if (r < 4224) { r -= 2816; j.W = p.in[4] + (size_t)l * 5632 * 2048; j.ldw = 2048; j.K = 5632; j.Wt = (bf16_t*)(p.ws + OFF_WD + (size_t)(0 * 2 + l) * SZ_WD); tilesN = 32; }
    else if (r < 5760) { r -= 4224; j.W = p.in[7] + (size_t)l * 2048 * 6160; j.ldw = 6160; j.K = 2048; j.Wt = (bf16_t*)(p.ws + OFF_WIN + (size_t)l * SZ_WIN); tilesN = 96; }
    else if (r < 6272) { r -= 5760; j.W = p.in[16] + (size_t)l * 2048 * 2048; j.ldw = 2048; j.K = 2048; j.Wt = (bf16_t*)(p.ws + OFF_WOUT + (size_t)l * SZ_WSQ); tilesN = 32; }
    else if (r < 6784) { r -= 6272; j.W = p.in[20] + (size_t)l * 2048 * 2048; j.ldw = 2048; j.K = 2048; j.Wt = (bf16_t*)(p.ws + OFF_WXQ + (size_t)l * SZ_WSQ); tilesN = 32; }
    else if (r < 7808) { r -= 6784; j.W = p.in[21] + (size_t)l * 2048 * 4096; j.ldw = 4096; j.K = 2048; j.Wt = (bf16_t*)(p.ws + OFF_WKV + (size_t)l * SZ_WKV); tilesN = 64; }
    else if (r < 8320) { r -= 7808; j.W = p.in[22] + (size_t)l * 2048 * 2048; j.ldw = 2048; j.K = 2048; j.Wt = (bf16_t*)(p.ws + OFF_WXO + (size_t)l * SZ_WSQ); tilesN = 32; }
    else if (r < 11136) { r -= 8320; j.W = p.in[25] + (size_t)l * 2048 * 11264; j.ldw = 11264; j.K = 2048; j.Wt = (bf16_t*)(p.ws + OFF_WGU + (size_t)(1 * 2 + l) * SZ_WGU); tilesN = 176; il = true; }
    else { r -= 11136; j.W = p.in[26] + (size_t)l * 5632 * 2048; j.ldw = 2048; j.K = 5632; j.Wt = (bf16_t*)(p.ws + OFF_WD + (size_t)(1 * 2 + l) * SZ_WD); tilesN = 32; }
    const int kt = r / tilesN, nt = r - kt * tilesN; j.k0 = kt * 128; j.n0 = nt * 64;
    j.sc0 = il ? (((j.n0 >> 7) & 1) * 5632 + (j.n0 >> 8) * 128 + (j.n0 & 127)) : j.n0;
    return j;
}
__device__ __forceinline__ void phase0(LAS unsigned char* lds, const P& p) {
    const int tid = opaque_tid();
    LAS float* tl = (LAS float*)lds;
    const int c4 = (tid & 15) * 4, kr = tid >> 4;
    const int kg = tid & 15, nr = tid >> 4;
    constexpr int TOTAL = 2 * 12544;
#pragma unroll 1
    for (int rep_ = 0; rep_ < REP_CONV; ++rep_) {
    int g = blockIdx.x;
    f32x4 v[4]; ConvJob j;
    if (g < TOTAL) { j = conv_decode(p, g);
#pragma unroll
        for (int i = 0; i < 4; ++i) v[i] = *(const f32x4*)(j.W + (size_t)(j.k0 + kr + 32 * i) * j.ldw + j.sc0 + c4); }
    while (g < TOTAL) {
#pragma unroll
        for (int i = 0; i < 4; ++i) { const int k = kr + 32 * i; tl[(c4 + 0) * 129 + k] = v[i].x; tl[(c4 + 1) * 129 + k] = v[i].y; tl[(c4 + 2) * 129 + k] = v[i].z; tl[(c4 + 3) * 129 + k] = v[i].w; }
        __syncthreads();
        const ConvJob cj = j; const int gn = g + gridDim.x;
        if (gn < TOTAL) { j = conv_decode(p, gn);
#pragma unroll
            for (int i = 0; i < 4; ++i) v[i] = *(const f32x4*)(j.W + (size_t)(j.k0 + kr + 32 * i) * j.ldw + j.sc0 + c4); }
#pragma unroll
        for (int i = 0; i < 2; ++i) { const int n = nr + 32 * i; const LAS float* s = tl + n * 129 + kg * 8;
            u32x4 w; w.x = pk2(s[0], s[1]); w.y = pk2(s[2], s[3]); w.z = pk2(s[4], s[5]); w.w = pk2(s[6], s[7]);
            *(u32x4*)(cj.Wt + (size_t)(cj.n0 + n) * cj.K + cj.k0 + kg * 8) = w; }
        __syncthreads();
        g = gn;
    }
    }
    { const int gt = blockIdx.x * 512 + tid, gn = gridDim.x * 512;
      for (int e = gt; e < 2 * 16 * 2048; e += gn) { const int l = e >> 15, n = (e >> 11) & 15, k = e & 2047;
          ((bf16_t*)(p.ws + OFF_WBA))[e] = (bf16_t)(pk2(p.in[7][((size_t)l * 2048 + k) * 6160 + 6144 + n], 0.f) & 0xffffu); }
    }
    rowpass(T_, nullptr, nullptr, 0.f, p.in[0], p.out, p.in[2], (bf16_t*)(p.ws + OFF_H));
    rowpass(1024, nullptr, nullptr, 0.f, p.in[1], nullptr, p.in[19], (bf16_t*)(p.ws + OFF_MEMH));
    rowpass(1024, nullptr, nullptr, 0.f, p.in[1], nullptr, p.in[19] + 2048, (bf16_t*)(p.ws + OFF_MEMH) + (size_t)1024 * 2048);
}

__device__ __forceinline__ void wy_unit(LAS unsigned char* lds, const P& p, int l, int uid) {
    const int tid = opaque_tid(), lane = tid & 63, wv = tid >> 6;
    const int bh = uid >> 5, n = uid & 31, b = bh >> 3, hh = bh & 7;
    const int t0 = b * 2048 + n * 64;
    LAS float* sq = (LAS float*)lds; LAS float* sk = sq + 64 * 132; LAS float* sv = sk + 64 * 132; LAS float* sL = sv + 64 * 132;
    LAS float* sgc = sL + 64 * 64; LAS float* sbeta = sgc + 64; LAS float* segc = sbeta + 64;
    const bf16_t* proj = (const bf16_t*)(p.ws + OFF_BIG);
    const float* cw = p.in[8] + (size_t)l * 4 * 3072;
    bf16_t* DW = (bf16_t*)(p.ws + OFF_DW); float* DU = (float*)(p.ws + OFF_DU); bf16_t* DQG = (bf16_t*)(p.ws + OFF_DQG);
    bf16_t* DKT = (bf16_t*)(p.ws + OFF_DKT); bf16_t* DA = (bf16_t*)(p.ws + OFF_DA); float* DEG = (float*)(p.ws + OFF_DEG);
    {
        const int d = tid & 127, tb = (tid >> 7) * 16; const int tseq = n * 64 + tb;
#pragma unroll
        for (int which = 0; which < 3; ++which) {
            const int ch = which * 1024 + hh * 128 + d;
            const float w0 = cw[ch], w1 = cw[3072 + ch], w2 = cw[2 * 3072 + ch], w3 = cw[3 * 3072 + ch];
            const bf16_t* src = proj + (size_t)(t0 + tb) * 6144 + 2048 + ch;
            float xs[19];
            xs[0] = tseq >= 3 ? bf2f(*(src - 3 * 6144)) : 0.f; xs[1] = tseq >= 2 ? bf2f(*(src - 2 * 6144)) : 0.f; xs[2] = tseq >= 1 ? bf2f(*(src - 6144)) : 0.f;
#pragma unroll
            for (int i = 0; i < 16; ++i) xs[3 + i] = bf2f(src[(size_t)i * 6144]);
            LAS float* dst = (which == 0 ? sq : (which == 1 ? sk : sv)) + tb * 132 + d;
#pragma unroll
            for (int i = 0; i < 16; ++i) { const float y = w0 * xs[i] + w1 * xs[i + 1] + w2 * xs[i + 2] + w3 * xs[i + 3]; dst[i * 132] = silu_f(y); }
        }
    }
    if (wv == 0) {
        const float* bg = (const float*)(p.ws + OFF_BG) + (size_t)(t0 + lane) * 16;
        const float beta = bg[hh]; float g = bg[8 + hh];
#pragma unroll
        for (int o = 1; o < 64; o <<= 1) { const float t = __shfl_up(g, o); if (lane >= o) g += t; }
        sgc[lane] = g; sbeta[lane] = beta; segc[lane] = __expf(g);
    }
    __syncthreads();
    for (int i = 0; i < 8; ++i) { const int t = wv * 8 + i;
        { const float a0 = sq[t * 132 + lane], a1 = sq[t * 132 + 64 + lane]; const float r = rsqrtf(wave_sum(a0 * a0 + a1 * a1) + EPS) * 0.08838834764831845f; sq[t * 132 + lane] = a0 * r; sq[t * 132 + 64 + lane] = a1 * r; }
        { const float a0 = sk[t * 132 + lane], a1 = sk[t * 132 + 64 + lane]; const float r = rsqrtf(wave_sum(a0 * a0 + a1 * a1) + EPS); sk[t * 132 + lane] = a0 * r; sk[t * 132 + 64 + lane] = a1 * r; }
    }
    __syncthreads();
    {
        const int ti = wv >> 1, sp = wv & 1, r16 = lane & 15, g4 = lane >> 4;
        f32x4 akk0 = {0.f, 0.f, 0.f, 0.f}, akk1 = akk0, aqk0 = akk0, aqk1 = akk0;
        if (2 * sp <= ti) {
#pragma unroll 2
            for (int st = 0; st < 8; ++st) { const int dofs = st * 16 + g4 * 4;
                const f32x4 kt = *(const LAS f32x4*)(sk + (16 * ti + r16) * 132 + dofs), qt = *(const LAS f32x4*)(sq + (16 * ti + r16) * 132 + dofs);
                const f32x4 ks0 = *(const LAS f32x4*)(sk + (32 * sp + r16) * 132 + dofs), ks1 = *(const LAS f32x4*)(sk + (32 * sp + 16 + r16) * 132 + dofs);
#pragma unroll
                for (int c = 0; c < 4; ++c) { akk0 = MFMA4F(kt[c], ks0[c], akk0); aqk0 = MFMA4F(qt[c], ks0[c], aqk0); akk1 = MFMA4F(kt[c], ks1[c], akk1); aqk1 = MFMA4F(qt[c], ks1[c], aqk1); } }
        }
#pragma unroll
        for (int e = 0; e < 2; ++e) { const f32x4 akk = e ? akk1 : akk0, aqk = e ? aqk1 : aqk0; const int s = 32 * sp + 16 * e + r16; const float gs = sgc[s];
#pragma unroll
            for (int r = 0; r < 4; ++r) { const int t = 16 * ti + 4 * g4 + r; const float dec = (s <= t) ? __expf(fminf(sgc[t] - gs, 0.f)) : 0.f;
                sL[t * 64 + s] = (s < t) ? sbeta[t] * akk[r] * dec : 0.f;
                DA[((size_t)uid * 64 + t) * 64 + s] = (bf16_t)(pk2(aqk[r] * dec, 0.f) & 0xffffu); } }
    }
    __syncthreads();
    LAS float* sT = segc + 64;
    if (wv == 0) {
        const int bi = lane >> 4, j = lane & 15; float x[16];
#pragma unroll
        for (int i = 0; i < 16; ++i) { float a = (i == j) ? 1.0f : 0.0f;
#pragma unroll
            for (int q = 0; q < (i + 3) / 4; ++q) { const f32x4 lv = *(const LAS f32x4*)(sL + (16 * bi + i) * 64 + 16 * bi + 4 * q);
                if (4 * q + 0 < i) a -= lv.x * x[4 * q + 0]; if (4 * q + 1 < i) a -= lv.y * x[4 * q + 1]; if (4 * q + 2 < i) a -= lv.z * x[4 * q + 2]; if (4 * q + 3 < i) a -= lv.w * x[4 * q + 3]; }
            x[i] = a; sT[bi * 320 + i * 20 + j] = a; }
    } else {
        const float gl = sgc[63];
        for (int e = tid - 64; e < 4096; e += 448) { const int t = e >> 6, d2 = (e & 63) * 2; const float ee = segc[t]; const f32x2 qv = *(const LAS f32x2*)(sq + t * 132 + d2);
            *(unsigned*)(DQG + ((size_t)uid * 64 + t) * 128 + d2) = pk2(qv.x * ee, qv.y * ee); }
        for (int e = tid - 64; e < 4096; e += 448) { const int d = e >> 5, t2 = (e & 31) * 2; const float e0 = __expf(gl - sgc[t2]), e1 = __expf(gl - sgc[t2 + 1]);
            *(unsigned*)(DKT + ((size_t)uid * 128 + d) * 64 + t2) = pk2(sk[t2 * 132 + d] * e0, sk[(t2 + 1) * 132 + d] * e1); }
        if (tid == 64) DEG[uid] = segc[63];
    }
    __syncthreads();
    {
        const int r16 = lane & 15, g4 = lane >> 4; const bool isu = wv < 4;
        const LAS float* src = isu ? (sv + 32 * wv + r16) : (sk + 32 * (wv - 4) + r16);
        f32x4 sol[4][2];
#pragma unroll
        for (int bi = 0; bi < 4; ++bi) {
            f32x4 acc[2];
#pragma unroll
            for (int r = 0; r < 4; ++r) { const int t = 16 * bi + 4 * g4 + r; const float sc = sbeta[t] * (isu ? 1.0f : segc[t]); acc[0][r] = src[t * 132] * sc; acc[1][r] = src[t * 132 + 16] * sc; }
#pragma unroll
            for (int bj = 0; bj < bi; ++bj) { const f32x4 lv = *(const LAS f32x4*)(sL + (16 * bi + r16) * 64 + 16 * bj + 4 * g4);
#pragma unroll
                for (int c = 0; c < 4; ++c) { acc[0] = MFMA4F(-lv[c], sol[bj][0][c], acc[0]); acc[1] = MFMA4F(-lv[c], sol[bj][1][c], acc[1]); } }
            const f32x4 tt = *(const LAS f32x4*)(sT + bi * 320 + r16 * 20 + 4 * g4);
            f32x4 z0 = {0.f, 0.f, 0.f, 0.f}, z1 = z0;
#pragma unroll
            for (int c = 0; c < 4; ++c) { z0 = MFMA4F(tt[c], acc[0][c], z0); z1 = MFMA4F(tt[c], acc[1][c], z1); }
            sol[bi][0] = z0; sol[bi][1] = z1;
#pragma unroll
            for (int r = 0; r < 4; ++r) { const int t = 16 * bi + 4 * g4 + r;
                if (isu) { float* up = DU + ((size_t)uid * 64 + t) * 128 + 32 * wv + r16; up[0] = z0[r]; up[16] = z1[r]; }
                else { bf16_t* wp = DW + ((size_t)uid * 64 + t) * 128 + 32 * (wv - 4) + r16; wp[0] = (bf16_t)(pk2(z0[r], 0.f) & 0xffffu); wp[16] = (bf16_t)(pk2(z1[r], 0.f) & 0xffffu); } }
        }
    }
    __syncthreads();
}

__device__ __forceinline__ void sgu_unit(LAS unsigned char* lds, const P& p, int l, int uid) {
    const int tid = opaque_tid(), lane = tid & 63, wv = tid >> 6, r16 = lane & 15, g4 = lane >> 4;
    const int hh = uid & 7, t0 = (uid >> 3) * 128;
    LAS bf16_t* vT = (LAS bf16_t*)lds;
    const bf16_t* proj = (const bf16_t*)(p.ws + OFF_BIG);
    const float* stats = (const float*)(p.ws + OFF_STATS) + (size_t)l * T_ * 32;
    const float* lng = p.in[13] + l * 1024 + hh * 128; const float* lnb = p.in[14] + l * 1024 + hh * 128;
    {
        const int s = tid & 127, dgb = tid >> 7;
        float su = 0.f, sqq = 0.f;
#pragma unroll
        for (int i = 0; i < 8; ++i) { const f32x4 pv = *(const f32x4*)(stats + (size_t)(t0 + s) * 32 + 4 * i); su += pv.x + pv.z; sqq += pv.y + pv.w; }
        const float mu = su * (1.0f / 1024.0f); const float var = fmaxf(sqq * (1.0f / 1024.0f) - mu * mu, 0.f); const float rs = rsqrtf(var + EPS);
#pragma unroll
        for (int i = 0; i < 4; ++i) { const int dg = dgb + 4 * i;
            const u32x4 raw = *(const u32x4*)(proj + (size_t)(t0 + s) * 6144 + 1024 + hh * 128 + dg * 8);
            const f32x4 ga = *(const f32x4*)(lng + dg * 8), gb = *(const f32x4*)(lng + dg * 8 + 4), ba = *(const f32x4*)(lnb + dg * 8), bb = *(const f32x4*)(lnb + dg * 8 + 4);
            float vv[8] = {bf2f(raw.x & 0xffffu), bf2f(raw.x >> 16), bf2f(raw.y & 0xffffu), bf2f(raw.y >> 16), bf2f(raw.z & 0xffffu), bf2f(raw.z >> 16), bf2f(raw.w & 0xffffu), bf2f(raw.w >> 16)};
            const float gg[8] = {ga.x, ga.y, ga.z, ga.w, gb.x, gb.y, gb.z, gb.w}, bbv[8] = {ba.x, ba.y, ba.z, ba.w, bb.x, bb.y, bb.z, bb.w};
#pragma unroll
            for (int e = 0; e < 8; ++e) vT[(dg * 8 + e) * 136 + s] = (bf16_t)(pk2((vv[e] - mu) * rs * gg[e] + bbv[e], 0.f) & 0xffffu); }
    }
    __syncthreads();
    const int t = 16 * wv + r16;
    const float* wm = p.in[11] + (((size_t)l * 8 + hh) * 128 + t) * 128;
    const int nkk = (16 * wv + 15) / 32 + 1;
    f32x4 acc[8];
#pragma unroll
    for (int i = 0; i < 8; ++i) acc[i] = (f32x4){0.f, 0.f, 0.f, 0.f};
    for (int kk = 0; kk < nkk; ++kk) { const int s0 = 32 * kk + 8 * g4;
        f32x4 w0 = *(const f32x4*)(wm + s0), w1 = *(const f32x4*)(wm + s0 + 4);
#pragma unroll
        for (int c = 0; c < 4; ++c) { if (s0 + c > t) w0[c] = 0.f; if (s0 + 4 + c > t) w1[c] = 0.f; }
        const bf16x8 af = mk8(pk2(w0.x, w0.y), pk2(w0.z, w0.w), pk2(w1.x, w1.y), pk2(w1.z, w1.w));
#pragma unroll
        for (int nt = 0; nt < 8; ++nt) { const bf16x8 bfr = *(const LAS bf16x8*)(vT + (16 * nt + r16) * 136 + s0); acc[nt] = MFMA16(bfr, af, acc[nt]); } }
    const float bias = p.in[12][((size_t)l * 8 + hh) * 128 + t];
    const bf16_t* gu = proj + (size_t)(t0 + t) * 6144 + hh * 128; bf16_t* yo = (bf16_t*)(p.ws + OFF_Y) + (size_t)(t0 + t) * 2048 + hh * 128;
#pragma unroll
    for (int nt = 0; nt < 8; ++nt) { const int d = 16 * nt + 4 * g4; const u32x2 gr = *(const u32x2*)(gu + d);
        u32x2 w; w.x = pk2(bf2f(gr.x & 0xffffu) * (acc[nt].x + bias), bf2f(gr.x >> 16) * (acc[nt].y + bias)); w.y = pk2(bf2f(gr.y & 0xffffu) * (acc[nt].z + bias), bf2f(gr.y >> 16) * (acc[nt].w + bias));
        *(u32x2*)(yo + d) = w; }
    __syncthreads();
}

__device__ __forceinline__ void scan_unit(LAS unsigned char* lds, const P& p, int bh, int sl) {
    const int tid = opaque_tid(), lane = tid & 63, wv = tid >> 6, r16 = lane & 15, g4 = lane >> 4;
    LAS bf16_t* ST = (LAS bf16_t*)lds;
    LAS bf16_t* VN = ST + 16 * 136;
    const int b = bh >> 3, hh = bh & 7, grp = wv >> 2, rt = wv & 3;
    const bf16_t* DW = (const bf16_t*)(p.ws + OFF_DW); const float* DU = (const float*)(p.ws + OFF_DU); const bf16_t* DQG = (const bf16_t*)(p.ws + OFF_DQG);
    const bf16_t* DKT = (const bf16_t*)(p.ws + OFF_DKT); const bf16_t* DA = (const bf16_t*)(p.ws + OFF_DA); const float* DEG = (const float*)(p.ws + OFF_DEG);
    float* O = (float*)(p.ws + OFF_F);
    for (int i = tid; i < 16 * 136 / 2; i += 512) ((LAS unsigned*)ST)[i] = 0u;
    f32x4 sacc = {0.f, 0.f, 0.f, 0.f};
    __syncthreads();
    const bf16_t* a1b = (grp == 0 ? DW : DQG) + ((size_t)(bh * 32) * 64 + 16 * rt + r16) * 128 + 8 * g4;
    const bf16_t* a3b = DKT + ((size_t)(bh * 32) * 128 + 16 * wv + r16) * 64 + 8 * g4;
    const bf16_t* a2b = DA + ((size_t)(bh * 32) * 64 + 16 * rt + r16) * 64 + 8 * g4;
    const float* upb = DU + ((size_t)(bh * 32) * 64 + 16 * rt + 4 * g4) * 128 + sl * 16 + r16;
    bf16x8 af[4], kf[2], aa[2]; f32x4 uu; float eg;
#define SCAN_LOAD(n_) do { const int n__ = (n_); \
        _Pragma("unroll") for (int kk = 0; kk < 4; ++kk) af[kk] = *(const bf16x8*)(a1b + (size_t)n__ * 64 * 128 + 32 * kk); \
        kf[0] = *(const bf16x8*)(a3b + (size_t)n__ * 128 * 64); kf[1] = *(const bf16x8*)(a3b + (size_t)n__ * 128 * 64 + 32); \
        aa[0] = *(const bf16x8*)(a2b + (size_t)n__ * 64 * 64); aa[1] = *(const bf16x8*)(a2b + (size_t)n__ * 64 * 64 + 32); \
        { const float* up = upb + (size_t)n__ * 64 * 128; uu = (f32x4){up[0], up[128], up[256], up[384]}; } \
        eg = DEG[bh * 32 + n__]; } while (0)
    SCAN_LOAD(0);
    for (int n = 0; n < 32; ++n) {
        bf16x8 caf[4] = {af[0], af[1], af[2], af[3]}, ckf[2] = {kf[0], kf[1]}, caa[2] = {aa[0], aa[1]}; const f32x4 cuu = uu; const float ceg = eg;
        if (n + 1 < 32) SCAN_LOAD(n + 1);
        f32x4 acc1 = {0.f, 0.f, 0.f, 0.f};
#pragma unroll
        for (int kk = 0; kk < 4; ++kk) { const bf16x8 bfr = *(const LAS bf16x8*)(ST + r16 * 136 + 32 * kk + 8 * g4); acc1 = MFMA16(caf[kk], bfr, acc1); }
        if (grp == 0) { const f32x4 vn = cuu - acc1; u32x2 w; w.x = pk2(vn.x, vn.y); w.y = pk2(vn.z, vn.w); *(LAS u32x2*)(VN + r16 * 72 + 16 * rt + 4 * g4) = w; }
        LDS_BAR();
        const bf16x8 v0 = *(const LAS bf16x8*)(VN + r16 * 72 + 8 * g4), v1 = *(const LAS bf16x8*)(VN + r16 * 72 + 32 + 8 * g4);
        if (grp == 1) { acc1 = MFMA16(caa[0], v0, acc1); acc1 = MFMA16(caa[1], v1, acc1);
            float* op = O + ((size_t)(b * 2048 + n * 64 + 16 * rt + 4 * g4)) * 1024 + hh * 128 + sl * 16 + r16;
            op[0] = acc1.x; op[1024] = acc1.y; op[2048] = acc1.z; op[3072] = acc1.w; }
        sacc *= ceg;
        sacc = MFMA16(ckf[0], v0, sacc); sacc = MFMA16(ckf[1], v1, sacc);
        { u32x2 w; w.x = pk2(sacc.x, sacc.y); w.y = pk2(sacc.z, sacc.w); *(LAS u32x2*)(ST + r16 * 136 + 16 * wv + 4 * g4) = w; }
        LDS_BAR();
    }
#undef SCAN_LOAD
}

__device__ __forceinline__ void attn_unit(LAS unsigned char* lds, const P& p, int l, int uid) {
    const int tid = opaque_tid(), lane = tid & 63, wv = tid >> 6, r16 = lane & 15, g4 = lane >> 4;
    const int b = uid >> 6, hh = (uid >> 4) & 3, qt = uid & 15; const int t0 = b * 2048 + qt * 128;
    const bf16_t* kbase = (const bf16_t*)(p.ws + OFF_KB) + (size_t)l * 1024 * 2048 + (size_t)(b * 256) * 2048 + hh * 512;
    const bf16_t* vbase = (const bf16_t*)(p.ws + OFF_VT) + (size_t)l * 1024 * 2048 + (size_t)((b * 4 + hh) * 512) * 256;
    const bf16_t* qrow = (const bf16_t*)(p.ws + OFF_Y) + (size_t)(t0 + 16 * wv + r16) * 2048 + hh * 512 + 8 * g4;
    bf16_t* orow = (bf16_t*)(p.ws + OFF_AO) + (size_t)(t0 + 16 * wv + r16) * 2048 + hh * 512 + 4 * g4;
    u32x4 pre[4];
#define ATT_LOADK(dc) do { _Pragma("unroll") for (int i = 0; i < 4; ++i) { const int pi = tid + 512 * i; pre[i] = *(const u32x4*)(kbase + (size_t)(pi >> 3) * 2048 + (dc) * 64 + (pi & 7) * 8); } } while (0)
#define ATT_WRITEK(buf) do { _Pragma("unroll") for (int i = 0; i < 4; ++i) { const int pi = tid + 512 * i; *(LAS u32x4*)((buf) + (pi >> 3) * 144 + (pi & 7) * 16) = pre[i]; } } while (0)
#define ATT_LOADV(dc) do { _Pragma("unroll") for (int i = 0; i < 4; ++i) { const int pi = tid + 512 * i; pre[i] = *(const u32x4*)(vbase + (size_t)((dc) * 64 + (pi >> 5)) * 256 + (pi & 31) * 8); } } while (0)
#define ATT_WRITEV(buf) do { _Pragma("unroll") for (int i = 0; i < 4; ++i) { const int pi = tid + 512 * i; *(LAS u32x4*)((buf) + (pi >> 5) * 528 + (pi & 31) * 16) = pre[i]; } } while (0)
    f32x4 sacc[16];
#pragma unroll
    for (int i = 0; i < 16; ++i) sacc[i] = (f32x4){0.f, 0.f, 0.f, 0.f};
    ATT_LOADK(0); ATT_WRITEK(lds); __syncthreads();
    for (int dc = 0; dc < 8; ++dc) {
        LAS unsigned char* cur = lds + (dc & 1) * 36864; LAS unsigned char* nxt = lds + ((dc + 1) & 1) * 36864;
        if (dc < 7) ATT_LOADK(dc + 1); else ATT_LOADV(0);
        const bf16x8 qf0 = *(const bf16x8*)(qrow + dc * 64), qf1 = *(const bf16x8*)(qrow + dc * 64 + 32);
#pragma unroll
        for (int n = 0; n < 16; ++n) { const LAS unsigned char* rp = cur + (16 * n + r16) * 144 + g4 * 16;
            const bf16x8 kf0 = *(const LAS bf16x8*)rp, kf1 = *(const LAS bf16x8*)(rp + 64);
            sacc[n] = MFMA16(kf0, qf0, sacc[n]); sacc[n] = MFMA16(kf1, qf1, sacc[n]); }
        if (dc < 7) ATT_WRITEK(nxt); else ATT_WRITEV(nxt);
        __syncthreads();
    }
    float mx = -3.0e38f;
#pragma unroll
    for (int n = 0; n < 16; ++n) mx = fmaxf(mx, fmaxf(fmaxf(sacc[n].x, sacc[n].y), fmaxf(sacc[n].z, sacc[n].w)));
    mx = fmaxf(mx, __shfl_xor(mx, 16)); mx = fmaxf(mx, __shfl_xor(mx, 32));
    float sum = 0.f;
#pragma unroll
    for (int n = 0; n < 16; ++n) {
#pragma unroll
        for (int r = 0; r < 4; ++r) { const float e = exp2f((sacc[n][r] - mx) * 1.4426950408889634f); sacc[n][r] = e; sum += e; } }
    sum += __shfl_xor(sum, 16); sum += __shfl_xor(sum, 32);
    const float inv = 1.0f / sum;
    bf16x8 pf[8];
#pragma unroll
    for (int kk = 0; kk < 8; ++kk) pf[kk] = mk8(pk2(sacc[2 * kk].x, sacc[2 * kk].y), pk2(sacc[2 * kk].z, sacc[2 * kk].w), pk2(sacc[2 * kk + 1].x, sacc[2 * kk + 1].y), pk2(sacc[2 * kk + 1].z, sacc[2 * kk + 1].w));
    for (int dc = 0; dc < 8; ++dc) {
        LAS unsigned char* cur = lds + (dc & 1) * 36864; LAS unsigned char* nxt = lds + ((dc + 1) & 1) * 36864;
        if (dc < 7) ATT_LOADV(dc + 1);
        f32x4 oacc[4];
#pragma unroll
        for (int nd = 0; nd < 4; ++nd) { oacc[nd] = (f32x4){0.f, 0.f, 0.f, 0.f}; const LAS unsigned char* rp = cur + (16 * nd + r16) * 528 + g4 * 8;
#pragma unroll
            for (int kk = 0; kk < 8; ++kk) { const u32x2 lo = *(const LAS u32x2*)(rp + kk * 64), hi = *(const LAS u32x2*)(rp + kk * 64 + 32);
                oacc[nd] = MFMA16(mk8(lo.x, lo.y, hi.x, hi.y), pf[kk], oacc[nd]); } }
#pragma unroll
        for (int nd = 0; nd < 4; ++nd) { u32x2 w; w.x = pk2(oacc[nd].x * inv, oacc[nd].y * inv); w.y = pk2(oacc[nd].z * inv, oacc[nd].w * inv); *(u32x2*)(orow + dc * 64 + 16 * nd) = w; }
        if (dc < 7) ATT_WRITEV(nxt);
        __syncthreads();
    }
#undef ATT_LOADK
#undef ATT_WRITEK
#undef ATT_LOADV
#undef ATT_WRITEV
}

#if defined(DBG_STOP)
__device__ __forceinline__ float dbg_get(const void* p, int isf32, size_t idx) { return isf32 ? ((const float*)p)[idx] : bf2f(((const bf16_t*)p)[idx]); }
__device__ __forceinline__ void dbg_dump(float* out, const void* a, int af32, size_t lda, size_t a0, const void* b, int bf32, size_t ldb, size_t b0) {
    for (size_t i = (size_t)blockIdx.x * 512 + threadIdx.x; i < (size_t)T_ * 2048; i += (size_t)gridDim.x * 512) { const size_t t = i >> 11, c = i & 2047;
        out[i] = c < 1024 ? dbg_get(a, af32, t * lda + a0 + c) : dbg_get(b, bf32, t * ldb + b0 + (c - 1024)); } }
#endif
__global__ void __launch_bounds__(512, 2) mk_fwd(P p) {
    extern __shared__ __attribute__((aligned(16))) unsigned char lds_raw[];
    LAS unsigned char* lds = (LAS unsigned char*)lds_raw;
    cg::grid_group grid = cg::this_grid();
#define GSYNC_CG() do { asm volatile("s_waitcnt vmcnt(0) lgkmcnt(0)" ::: "memory"); __builtin_amdgcn_fence(__ATOMIC_RELEASE, "agent"); grid.sync(); __builtin_amdgcn_fence(__ATOMIC_ACQUIRE, "agent"); } while (0)
#define GSYNC() xcd_barrier(xbar)
    if (threadIdx.x < 4) ((LAS unsigned*)(lds + LDS_BYTES - 16))[threadIdx.x] = 0u;
    __syncthreads();
    const XcdBarrier xbar = xcd_barrier_post((unsigned*)(p.ws + OFF_BAR), (volatile LAS unsigned*)(lds + LDS_BYTES - 16));
    const int G = gridDim.x, bx = blockIdx.x;
    unsigned char* ws = p.ws;
    bf16_t* H = (bf16_t*)(ws + OFF_H); bf16_t* BIG = (bf16_t*)(ws + OFF_BIG); float* F = (float*)(ws + OFF_F); bf16_t* Y = (bf16_t*)(ws + OFF_Y); bf16_t* AO = (bf16_t*)(ws + OFF_AO);

    phase0(lds, p);
    GSYNC_CG();
#pragma unroll 1
    for (int l = 0; l < 2; ++l) {
#pragma unroll 1
        for (int ffn = 0; ffn < 2; ++ffn) {
            if (ffn == 1) {
                {
                    pg8::Gemm g{H, (const bf16_t*)(ws + OFF_WIN + (size_t)l * SZ_WIN), T_, 6144, 2048}; pg8::StaticOrder S; S.init(T_, 6144, G, bx);
                    pg8::EpiIn E{BIG, (float*)(ws + OFF_STATS) + (size_t)l * T_ * 32};
                    _Pragma("unroll 1") for (int rep_ = 0; rep_ < REP_GEMM; ++rep_) pg8::gemm_phase<pg8::EpiIn, pg8::StaticOrder>(lds, g, S, E, nullptr);
                    const float* alog = p.in[9] + l * 8; const float* dtb = p.in[10] + l * 8; float* BG = (float*)(ws + OFF_BG);
                    const int tid = opaque_tid(), lane = tid & 63, wv = tid >> 6, r16 = lane & 15, g4 = lane >> 4;
                    for (int rp = bx; rp < 256; rp += G) {
                        const int rt = 2 * rp + (wv >> 2), kq = wv & 3;
                        const bf16_t* ap = H + (size_t)(16 * rt + r16) * 2048 + 512 * kq + 8 * g4;
                        const bf16_t* bp = (const bf16_t*)(ws + OFF_WBA) + (size_t)l * 16 * 2048 + (size_t)r16 * 2048 + 512 * kq + 8 * g4;
                        f32x4 acc = {0.f, 0.f, 0.f, 0.f};
#pragma unroll 4
                        for (int kk = 0; kk < 16; ++kk) acc = MFMA16(*(const bf16x8*)(ap + 32 * kk), *(const bf16x8*)(bp + 32 * kk), acc);
                        LAS f32x4* red = (LAS f32x4*)lds; red[wv * 64 + lane] = acc; __syncthreads();
                        if (kq == 0) { const f32x4 s = red[wv * 64 + lane] + red[(wv + 1) * 64 + lane] + red[(wv + 2) * 64 + lane] + red[(wv + 3) * 64 + lane];
#pragma unroll
                            for (int r = 0; r < 4; ++r) { const float v = s[r]; float o;
                                if (r16 < 8) o = 1.0f / (1.0f + __expf(-v));
                                else { const float a = v + dtb[r16 - 8]; const float sp = a > 20.f ? a : log1pf(__expf(a)); o = -__expf(alog[r16 - 8]) * sp; }
                                BG[(size_t)(16 * rt + 4 * g4 + r) * 16 + r16] = o; } }
                        __syncthreads();
                    }
                }
                GSYNC();
#if defined(DBG_STOP)
                if (l == 0 && DBG_STOP == 5) { dbg_dump(p.out, BIG, 0, 6144, 0, BIG, 0, 6144, 1024); return; }
                if (l == 0 && DBG_STOP == 6) { dbg_dump(p.out, BIG, 0, 6144, 2048, BIG, 0, 6144, 3072); return; }
                if (l == 0 && DBG_STOP == 7) { dbg_dump(p.out, BIG, 0, 6144, 4096, BIG, 0, 6144, 5120); return; }
                if (l == 0 && DBG_STOP == 12) { dbg_dump(p.out, ws + OFF_BG, 1, 16, 0, ws + OFF_STATS, 1, 32, 0); return; }
#endif
                _Pragma("unroll 1") for (int rep_ = 0; rep_ < REP_WY; ++rep_) for (int u = bx; u < 1536; u += G) { if (u < 1024) wy_unit(lds, p, l, u); else sgu_unit(lds, p, l, u - 1024); }
                GSYNC();
#if defined(DBG_STOP)
                if (l == 0 && DBG_STOP == 8) { dbg_dump(p.out, Y, 0, 2048, 0, ws + OFF_DU, 1, 1024, 0); return; }
                if (l == 0 && DBG_STOP == 9) { dbg_dump(p.out, ws + OFF_DW, 0, 1024, 0, ws + OFF_DQG, 0, 1024, 0); return; }
                if (l == 0 && DBG_STOP == 10) { dbg_dump(p.out, ws + OFF_DKT, 0, 1024, 0, ws + OFF_DKT, 0, 1024, 0); return; }
                if (l == 0 && DBG_STOP == 14) { dbg_dump(p.out, ws + OFF_DA, 0, 256, (size_t)T_ * 256, ws + OFF_DEG, 1, 0, 0); return; }
                if (l == 0 && DBG_STOP == 13) { dbg_dump(p.out, ws + OFF_DA, 0, 256, 0, ws + OFF_DA, 0, 256, 0); return; }
#endif
                _Pragma("unroll 1") for (int rep_ = 0; rep_ < REP_SCAN; ++rep_) for (int u = bx; u < 256; u += G) scan_unit(lds, p, (u & 7) + 8 * (u >> 6), (u >> 3) & 7);
                GSYNC();
#if defined(DBG_STOP)
                if (l == 0 && DBG_STOP == 11) { dbg_dump(p.out, F, 1, 1024, 0, F, 1, 1024, 0); return; }
#endif
                {
                    const int tid = opaque_tid(), lane = tid & 63, wv = tid >> 6;
                    const float* O = F; const float* dnw = p.in[15] + l * 128; const float w0 = dnw[lane * 2], w1 = dnw[lane * 2 + 1];
                    for (int t = bx * 8 + wv; t < T_; t += G * 8) {
#pragma unroll
                        for (int hh = 0; hh < 8; ++hh) { const f32x2 ov = *(const f32x2*)(O + (size_t)t * 1024 + hh * 128 + lane * 2);
                            const float rs = rsqrtf(wave_sum(ov.x * ov.x + ov.y * ov.y) * (1.0f / 128.0f) + EPS);
                            const unsigned zr = *(const unsigned*)(BIG + (size_t)t * 6144 + 5120 + hh * 128 + lane * 2);
                            *(unsigned*)(Y + (size_t)t * 2048 + 1024 + hh * 128 + lane * 2) = pk2(ov.x * rs * w0 * pg8::silu_f(bf2f(zr & 0xffffu)), ov.y * rs * w1 * pg8::silu_f(bf2f(zr >> 16))); }
                    }
                }
                GSYNC();
                { pg8::Gemm g{Y, (const bf16_t*)(ws + OFF_WOUT + (size_t)l * SZ_WSQ), T_, 2048, 2048}; pg8::StaticOrder S; S.init(T_, 2048, G, bx); pg8::EpiF32 E{F, 2048, nullptr};
                  _Pragma("unroll 1") for (int rep_ = 0; rep_ < REP_GEMM; ++rep_) pg8::gemm_phase<pg8::EpiF32, pg8::StaticOrder>(lds, g, S, E, nullptr); }
                GSYNC();
                rowpass(T_, F, p.in[17] + l * 2048, 1.0f, p.out, p.out, p.in[18] + l * 2048, H);
#if defined(DBG_STOP)
                if (DBG_STOP == 2 && l == 0) return;
#endif
                GSYNC();
                { pg8::Gemm g{H, (const bf16_t*)(ws + OFF_WXQ + (size_t)l * SZ_WSQ), T_, 2048, 2048}; pg8::StaticOrder S; S.init(T_, 2048, G, bx); pg8::EpiScaleBf16 E{Y, 2048, 0.04419417382415922f};
                  _Pragma("unroll 1") for (int rep_ = 0; rep_ < REP_GEMM; ++rep_) pg8::gemm_phase<pg8::EpiScaleBf16, pg8::StaticOrder>(lds, g, S, E, nullptr); }
                GSYNC();
                _Pragma("unroll 1") for (int rep_ = 0; rep_ < REP_ATTN; ++rep_) for (int u = bx; u < 256; u += G) attn_unit(lds, p, l, u);
                GSYNC();
                { pg8::Gemm g{AO, (const bf16_t*)(ws + OFF_WXO + (size_t)l * SZ_WSQ), T_, 2048, 2048}; pg8::StaticOrder S; S.init(T_, 2048, G, bx); pg8::EpiF32 E{F, 2048, nullptr};
                  _Pragma("unroll 1") for (int rep_ = 0; rep_ < REP_GEMM; ++rep_) pg8::gemm_phase<pg8::EpiF32, pg8::StaticOrder>(lds, g, S, E, nullptr); }
                GSYNC();
                rowpass(T_, F, p.in[23] + l * 2048, 1.0f, p.out, p.out, p.in[24] + l * 2048, H);
#if defined(DBG_STOP)
                if (DBG_STOP == 3 && l == 0) return;
#endif
                GSYNC();
            }
            { pg8::Gemm g{H, (const bf16_t*)(ws + OFF_WGU + (size_t)(ffn * 2 + l) * SZ_WGU), T_, 11264, 2048}; pg8::StaticOrder S; S.init(T_, 11264, G, bx); pg8::EpiSwiglu E{BIG};
              _Pragma("unroll 1") for (int rep_ = 0; rep_ < REP_GEMM; ++rep_) pg8::gemm_phase<pg8::EpiSwiglu, pg8::StaticOrder>(lds, g, S, E, nullptr);
              if (l == 0 && ffn == 0) {
#pragma unroll 1
                  for (int ll = 0; ll < 2; ++ll) {
                      pg8::Gemm g2{(const bf16_t*)(ws + OFF_MEMH) + (size_t)ll * 1024 * 2048, (const bf16_t*)(ws + OFF_WKV + (size_t)ll * SZ_WKV), 1024, 4096, 2048};
                      pg8::TailOrder S2{G, bx, 64 * ll, 64, 16};
                      pg8::EpiKV E2{(bf16_t*)(ws + OFF_KB) + (size_t)ll * 1024 * 2048, (bf16_t*)(ws + OFF_VT) + (size_t)ll * 1024 * 2048};
                      _Pragma("unroll 1") for (int rep_ = 0; rep_ < REP_GEMM; ++rep_) pg8::gemm_phase<pg8::EpiKV, pg8::TailOrder>(lds, g2, S2, E2, nullptr); } } }
            GSYNC();
            { pg8::Gemm g{BIG, (const bf16_t*)(ws + OFF_WD + (size_t)(ffn * 2 + l) * SZ_WD), T_, 2048, 5632}; pg8::StaticOrder S; S.init(T_, 2048, G, bx); pg8::EpiF32 E{F, 2048, nullptr};
              _Pragma("unroll 1") for (int rep_ = 0; rep_ < REP_GEMM; ++rep_) pg8::gemm_phase<pg8::EpiF32, pg8::StaticOrder>(lds, g, S, E, nullptr); }
            GSYNC();
            {   const float* gpost = (ffn == 0 ? p.in[5] : p.in[27]) + l * 2048;
                const float* gpre = ffn == 0 ? p.in[6] + l * 2048 : (l == 0 ? p.in[2] + 2048 : nullptr);
                rowpass(T_, F, gpost, 0.5f, p.out, p.out, gpre, gpre ? H : nullptr); }
            _Pragma("unroll 1") for (int rep_ = 0; rep_ < REP_ROW; ++rep_) { GSYNC(); rowpass(T_, F, p.in[5], 0.0f, p.out, p.out, p.in[6], (bf16_t*)(ws + OFF_AO)); }
            _Pragma("unroll 1") for (int rep_ = 0; rep_ < REP_SYNC; ++rep_) { GSYNC(); }
#if defined(DBG_STOP)
            if (DBG_STOP == 1 && l == 0 && ffn == 0) return;
            if (DBG_STOP == 4 && l == 0 && ffn == 1) return;
#endif
            if (!(l == 1 && ffn == 1)) GSYNC();
        }
    }
}

extern "C" void kernel_launch(void* const* d_in, const int* in_sizes, int n_in, void* d_out, int out_size, void* d_ws, size_t ws_size, hipStream_t stream) {
    static int grid = 0;
    if (grid == 0) {
        int dev = 0, cus = 0, per_cu = 0;
        if (hipGetDevice(&dev) != hipSuccess || hipDeviceGetAttribute(&cus, hipDeviceAttributeMultiprocessorCount, dev) != hipSuccess) { fprintf(stderr, "kernel_launch: device query failed\n"); grid = -1; return; }
        if (hipFuncSetAttribute((const void*)mk_fwd, hipFuncAttributeMaxDynamicSharedMemorySize, LDS_BYTES) != hipSuccess) { fprintf(stderr, "kernel_launch: hipFuncSetAttribute failed\n"); grid = -1; return; }
        if (hipOccupancyMaxActiveBlocksPerMultiprocessor(&per_cu, (const void*)mk_fwd, 512, LDS_BYTES) != hipSuccess || per_cu < 1) fprintf(stderr, "kernel_launch: occupancy query says %d blocks per CU\n", per_cu);
        (void)hipGetLastError();
        if (n_in != 28 || ws_size < WS_END || cus != 256) { fprintf(stderr, "kernel_launch: unexpected setup n_in %d ws %zu (need %zu) cus %d\n", n_in, ws_size, (size_t)WS_END, cus); }
        grid = 256;
    }
    if (grid < 0) return;
    P a{};
    for (int i = 0; i < 28; ++i) a.in[i] = (const float*)d_in[i];
    a.out = (float*)d_out; a.ws = (unsigned char*)d_ws;
    if (hipMemsetAsync((unsigned char*)d_ws + OFF_BAR, 0, BAR_BYTES, stream) != hipSuccess) { fprintf(stderr, "kernel_launch: memset failed\n"); return; }
    void* args[] = {&a};
    const hipError_t e = hipLaunchCooperativeKernel((const void*)mk_fwd, dim3(grid), dim3(512), args, LDS_BYTES, stream);
    if (e != hipSuccess) fprintf(stderr, "kernel_launch: cooperative launch failed: %s\n", hipGetErrorString(e));
}
```
